# Optimizing an MI355X kernel written in HIP

```python
import jax, jax.numpy as jnp
from jax import lax
import numpy as np

D_MODEL = 1024
BATCH = 2
SEQ = 8192
DEPTH = 4

N_BRANCH = 4
BRANCH_WIDTH = D_MODEL // 2
CHUNK = 128
SG_GROUPS = 4
SG_GROUP_DIM = BRANCH_WIDTH // SG_GROUPS
CONV_WIDTH = 3
MLA_HEADS = 8
MLA_NOPE_DIM = 64
MLA_ROPE_DIM = 32
MLA_V_DIM = BRANCH_WIDTH // MLA_HEADS
MLA_Q_RANK = 256
MLA_KV_RANK = 128
ROPE_THETA = 10000.0
SB_HEADS = 8
SB_HEAD_DIM = BRANCH_WIDTH // SB_HEADS
Q_BLOCK = 128
D_FF = 4 * D_MODEL
NORM_EPS = 1e-6

COLS_SG = 2 * BRANCH_WIDTH
COLS_CONV = 3 * BRANCH_WIDTH
COLS_MLA = MLA_Q_RANK + MLA_KV_RANK + MLA_ROPE_DIM
COLS_SB = 3 * SB_HEADS * SB_HEAD_DIM
COLS_GATE = N_BRANCH * D_MODEL
SPLIT_POINTS = (COLS_SG, COLS_SG + COLS_CONV, COLS_SG + COLS_CONV + COLS_MLA,
                COLS_SG + COLS_CONV + COLS_MLA + COLS_SB)
IN_COLS = COLS_SG + COLS_CONV + COLS_MLA + COLS_SB + COLS_GATE

kernel_name = 'hybrid_gated_parallel_mixer_trunk'


def _rmsnorm(x, g):
    x32 = x.astype(jnp.float32)
    y = x32 * lax.rsqrt(jnp.mean(x32 * x32, axis=-1, keepdims=True) + NORM_EPS)
    return y.astype(x.dtype) * g


def _layernorm(x, g):
    x32 = x.astype(jnp.float32)
    xc = x32 - jnp.mean(x32, axis=-1, keepdims=True)
    y = xc * lax.rsqrt(jnp.mean(xc * xc, axis=-1, keepdims=True) + NORM_EPS)
    return y.astype(x.dtype) * g


def _rope(x, cos, sin):
    x1, x2 = jnp.split(x, 2, axis=-1)
    return jnp.concatenate([x1 * cos - x2 * sin, x2 * cos + x1 * sin], axis=-1)


def _to_blocks(t):
    b, s, h, d = t.shape
    return t.reshape(b, s // Q_BLOCK, Q_BLOCK, h, d).transpose(1, 0, 2, 3, 4)


def _from_blocks(o):
    nb, b, qb, h, d = o.shape
    return o.transpose(1, 0, 2, 3, 4).reshape(b, nb * qb, h * d)


def _spatial_gating(z, norm_g, w_s, b_s):
    bsz, seq, _ = z.shape
    u, v = jnp.split(jax.nn.gelu(z), 2, axis=-1)
    v = _layernorm(v, norm_g).reshape(bsz, seq // CHUNK, CHUNK, SG_GROUPS, SG_GROUP_DIM)
    causal = jnp.tril(jnp.ones((CHUNK, CHUNK), dtype=w_s.dtype))
    s = jnp.einsum('gts,bnsgc->bntgc', w_s * causal, v) + b_s.T[:, :, None]
    return u * s.reshape(bsz, seq, BRANCH_WIDTH)


def _short_conv(z, conv_w):
    gate_b, gate_c, xv = jnp.split(z, 3, axis=-1)
    t = gate_c * xv
    y = lax.conv_general_dilated(t, conv_w[:, None, :], window_strides=(1,),
                                 padding=[(CONV_WIDTH - 1, 0)],
                                 dimension_numbers=('NWC', 'WIO', 'NWC'),
                                 feature_group_count=BRANCH_WIDTH)
    return gate_b * y


def _latent_attention(z, cos, sin, q_norm_g, w_uq, kv_norm_g, w_ukv):
    bsz, seq, _ = z.shape
    c_q, c_kv, k_pe = jnp.split(z, [MLA_Q_RANK, MLA_Q_RANK + MLA_KV_RANK], axis=-1)
    q = (_rmsnorm(c_q, q_norm_g) @ w_uq).reshape(bsz, seq, MLA_HEADS, MLA_NOPE_DIM + MLA_ROPE_DIM)
    q_nope, q_pe = jnp.split(q, [MLA_NOPE_DIM], axis=-1)
    q_pe = _rope(q_pe, cos[:, :, None, :], sin[:, :, None, :])
    kv = (_rmsnorm(c_kv, kv_norm_g) @ w_ukv).reshape(bsz, seq, MLA_HEADS, MLA_NOPE_DIM + MLA_V_DIM)
    k_nope, v = jnp.split(kv, [MLA_NOPE_DIM], axis=-1)
    k_pe = _rope(k_pe, cos, sin)
    scale = (MLA_NOPE_DIM + MLA_ROPE_DIM) ** -0.5
    k_pos = jnp.arange(seq)

    def block(args):
        i, qn, qp = args
        q_pos = i * Q_BLOCK + jnp.arange(Q_BLOCK)
        s = (jnp.einsum('bqhd,bkhd->bhqk', qn, k_nope, preferred_element_type=jnp.float32)
             + jnp.einsum('bqhr,bkr->bhqk', qp, k_pe, preferred_element_type=jnp.float32)) * scale
        s = jnp.where(k_pos[None, :] <= q_pos[:, None], s, -jnp.inf)
        p = jax.nn.softmax(s, axis=-1).astype(v.dtype)
        return jnp.einsum('bhqk,bkhd->bqhd', p, v)

    out = lax.map(block, (jnp.arange(seq // Q_BLOCK), _to_blocks(q_nope), _to_blocks(q_pe)))
    return _from_blocks(out)


def _stick_breaking(z):
    bsz, seq, _ = z.shape
    q, k, v = [t.reshape(bsz, seq, SB_HEADS, SB_HEAD_DIM) for t in jnp.split(z, 3, axis=-1)]
    scale = SB_HEAD_DIM ** -0.5
    k_pos = jnp.arange(seq)

    def block(args):
        i, qb = args
        q_pos = i * Q_BLOCK + jnp.arange(Q_BLOCK)
        logits = jnp.einsum('bqhd,bkhd->bhqk', qb, k, preferred_element_type=jnp.float32) * scale
        mask = k_pos[None, :] < q_pos[:, None]
        log_1m = jnp.where(mask, jax.nn.log_sigmoid(-logits), 0.0)
        rev = lax.cumsum(log_1m, axis=3, reverse=True)
        between = jnp.concatenate([rev[..., 1:], jnp.zeros_like(rev[..., :1])], axis=-1)
        a = jnp.where(mask, jnp.exp(jax.nn.log_sigmoid(logits) + between), 0.0)
        return jnp.einsum('bhqk,bkhd->bqhd', a.astype(v.dtype), v)

    out = lax.map(block, (jnp.arange(seq // Q_BLOCK), _to_blocks(q)))
    return _from_blocks(out)


def _token_mixing(h, cos, sin, w_in, sg_norm_g, sg_w, sg_b, conv_w,
                  q_norm_g, w_uq, kv_norm_g, w_ukv, w_branch, w_out):
    bsz, seq, _ = h.shape
    z = h @ w_in
    z_sg, z_conv, z_mla, z_sb, z_gate = jnp.split(z, list(SPLIT_POINTS), axis=-1)
    ys = jnp.stack([
        _spatial_gating(z_sg, sg_norm_g, sg_w, sg_b),
        _short_conv(z_conv, conv_w),
        _latent_attention(z_mla, cos, sin, q_norm_g, w_uq, kv_norm_g, w_ukv),
        _stick_breaking(z_sb),
    ], axis=2)
    up = jnp.einsum('bsnw,nwd->bsnd', ys, w_branch)
    gates = jax.nn.sigmoid(z_gate).reshape(bsz, seq, N_BRANCH, D_MODEL)
    merged = jnp.sum(gates * up, axis=2)
    return merged @ w_out


def _squared_relu_mlp(h, w1, w2):
    return jnp.square(jax.nn.relu(h @ w1)) @ w2


def setup_inputs(seed: int = 0) -> dict:
    key = jax.random.key(seed)
    ks = jax.random.split(key, 21)
    f32 = jnp.float32

    def nrm(k, shape, scale):
        return jax.random.normal(k, shape, f32) * scale

    def gain(k, shape):
        return 1.0 + 0.02 * jax.random.normal(k, shape, f32)

    start = jax.random.randint(ks[2], (BATCH, 1), 0, 4096, dtype=jnp.int32)
    positions = start + jnp.arange(SEQ, dtype=jnp.int32)[None, :]
    return {
        'x': nrm(ks[0], (BATCH, SEQ, D_MODEL), 1.0),
        'c': nrm(ks[1], (BATCH, D_MODEL), 1.0),
        'positions': positions,
        'ada_w': nrm(ks[3], (DEPTH, D_MODEL, 6 * D_MODEL), 0.5 * D_MODEL ** -0.5),
        'ada_b': nrm(ks[4], (DEPTH, 6 * D_MODEL), 0.02),
        'norm1_g': gain(ks[5], (DEPTH, D_MODEL)),
        'norm2_g': gain(ks[6], (DEPTH, D_MODEL)),
        'w_in': nrm(ks[7], (DEPTH, D_MODEL, IN_COLS), D_MODEL ** -0.5),
        'sg_norm_g': gain(ks[8], (DEPTH, BRANCH_WIDTH)),
        'sg_w': nrm(ks[9], (DEPTH, SG_GROUPS, CHUNK, CHUNK), CHUNK ** -0.5),
        'sg_b': gain(ks[10], (DEPTH, SG_GROUPS, CHUNK)),
        'conv_w': nrm(ks[11], (DEPTH, CONV_WIDTH, BRANCH_WIDTH), CONV_WIDTH ** -0.5),
        'mla_q_norm_g': gain(ks[12], (DEPTH, MLA_Q_RANK)),
        'mla_w_uq': nrm(ks[13], (DEPTH, MLA_Q_RANK, MLA_HEADS * (MLA_NOPE_DIM + MLA_ROPE_DIM)), MLA_Q_RANK ** -0.5),
        'mla_kv_norm_g': gain(ks[14], (DEPTH, MLA_KV_RANK)),
        'mla_w_ukv': nrm(ks[15], (DEPTH, MLA_KV_RANK, MLA_HEADS * (MLA_NOPE_DIM + MLA_V_DIM)), MLA_KV_RANK ** -0.5),
        'w_branch': nrm(ks[16], (DEPTH, N_BRANCH, BRANCH_WIDTH, D_MODEL), BRANCH_WIDTH ** -0.5),
        'w_out': nrm(ks[17], (DEPTH, D_MODEL, D_MODEL), D_MODEL ** -0.5),
        'mlp_w1': nrm(ks[18], (DEPTH, D_MODEL, D_FF), D_MODEL ** -0.5),
        'mlp_w2': nrm(ks[19], (DEPTH, D_FF, D_MODEL), 0.5 * D_FF ** -0.5),
        'final_norm_g': gain(ks[20], (D_MODEL,)),
    }


def reference(x, c, positions, ada_w, ada_b, norm1_g, norm2_g, w_in, sg_norm_g, sg_w, sg_b,
              conv_w, mla_q_norm_g, mla_w_uq, mla_kv_norm_g, mla_w_ukv, w_branch, w_out,
              mlp_w1, mlp_w2, final_norm_g):
    inv_freq = ROPE_THETA ** (-jnp.arange(0, MLA_ROPE_DIM, 2, dtype=jnp.float32) / MLA_ROPE_DIM)
    ang = positions.astype(jnp.float32)[..., None] * inv_freq
    cos = jnp.cos(ang).astype(x.dtype)
    sin = jnp.sin(ang).astype(x.dtype)
    c_act = jax.nn.silu(c)
    for l in range(DEPTH):
        mod = c_act @ ada_w[l] + ada_b[l]
        sh1, sc1, g1, sh2, sc2, g2 = jnp.split(mod[:, None, :], 6, axis=-1)
        h = _rmsnorm(x, norm1_g[l]) * (1.0 + sc1) + sh1
        x = x + g1 * _token_mixing(h, cos, sin, w_in[l], sg_norm_g[l], sg_w[l], sg_b[l], conv_w[l],
                                   mla_q_norm_g[l], mla_w_uq[l], mla_kv_norm_g[l], mla_w_ukv[l],
                                   w_branch[l], w_out[l])
        h = _rmsnorm(x, norm2_g[l]) * (1.0 + sc2) + sh2
        x = x + g2 * _squared_relu_mlp(h, mlp_w1[l], mlp_w2[l])
    return _rmsnorm(x, final_norm_g)
```

```cpp
#include <hip/hip_runtime.h>
#include <hip/hip_cooperative_groups.h>
#include <cstdio>
#include <cstdint>
namespace cg = cooperative_groups;

#ifndef DBG
#define DBG 0
#endif

#define LAS __attribute__((address_space(3)))
typedef unsigned short bf16_t;
typedef short bf16x8 __attribute__((ext_vector_type(8)));
typedef short s16x4 __attribute__((ext_vector_type(4)));
typedef float f32x2 __attribute__((ext_vector_type(2)));
typedef float f32x4 __attribute__((ext_vector_type(4)));
typedef float f32x16 __attribute__((ext_vector_type(16)));
typedef unsigned u32x2 __attribute__((ext_vector_type(2)));
typedef unsigned u32x4 __attribute__((ext_vector_type(4)));
typedef __bf16 bf16x2_t __attribute__((ext_vector_type(2)));

constexpr int MT = 16384, SEQ = 8192, DM = 1024, NL = 4, DFF = 4096;
constexpr int IN_COLS = 8608, NPAD = 8704, ZA_LD = 4608, ZG_LD = 4096;
constexpr int ZA_SGU = 0, ZA_SGV = 512, ZA_CB = 1024, ZA_CC = 1536, ZA_CX = 2048, ZA_CQ = 2560, ZA_CKV = 2816, ZA_KPE = 2944, ZA_SBQ = 3072, ZA_SBK = 3584, ZA_SBV = 4096;
constexpr float NORM_EPS = 1e-6f;
constexpr float LOG2E = 1.4426950408889634f, LN2 = 0.6931471805599453f;
constexpr size_t MiB = 1u << 20;
constexpr size_t WS_CTL = 0, CTL_BYTES = 1 * MiB;
constexpr size_t WS_MOD = 65536;
constexpr size_t WS_COS = 1 * MiB, WS_SIN = 2 * MiB;
constexpr size_t WS_SGW = 3 * MiB;
constexpr size_t WS_WIN = 4 * MiB;
constexpr size_t WS_WUQ = 21 * MiB, WS_WUKV = 22 * MiB, WS_WBR = 23 * MiB, WS_WOUT = 27 * MiB, WS_W1 = 29 * MiB, WS_W2 = 37 * MiB;
constexpr size_t WS_H = 46 * MiB;
constexpr size_t WS_ZA = 78 * MiB;
constexpr size_t WS_ZG = 222 * MiB;
constexpr size_t WS_YS = 350 * MiB;
constexpr size_t WS_CQN = 414 * MiB, WS_CKVN = 422 * MiB, WS_KPE = 426 * MiB, WS_QM = 427 * MiB, WS_KVM = 451 * MiB, WS_END = 483 * MiB;
constexpr size_t WS_MGF = WS_ZA, WS_MGB = WS_ZA + 64 * MiB;
constexpr size_t WS_HMID = WS_ZG;

constexpr int LDS_BYTES = 135168;

__device__ __forceinline__ float bf2f(unsigned v) { return __uint_as_float(v << 16); }
__device__ __forceinline__ unsigned pk2(float lo, float hi) { f32x2 v = {lo, hi}; bf16x2_t b = __builtin_convertvector(v, bf16x2_t); return __builtin_bit_cast(unsigned, b); }
__device__ __forceinline__ bf16_t f2bf(float f) { return (bf16_t)(pk2(f, 0.f) & 0xffffu); }
__device__ __forceinline__ float shx(float v, int mask, int lane) { return __int_as_float(__builtin_amdgcn_ds_bpermute((lane ^ mask) << 2, __float_as_int(v))); }
__device__ __forceinline__ float shl(float v, int src) { return __int_as_float(__builtin_amdgcn_ds_bpermute(src << 2, __float_as_int(v))); }
__device__ __forceinline__ float rdl(float v, int src_uniform) { return __int_as_float(__builtin_amdgcn_readlane(__float_as_int(v), src_uniform)); }
__device__ __forceinline__ float wave_sum(float v, int lane) {
#pragma unroll
    for (int o = 1; o < 64; o <<= 1) v += shx(v, o, lane);
    return v;
}
__device__ __forceinline__ int crow(int r, int hi) { return (r & 3) + 8 * (r >> 2) + 4 * hi; }
__device__ __forceinline__ float fexp2(float x) { return __builtin_amdgcn_exp2f(x); }
__device__ __forceinline__ float flog2(float x) { return __builtin_amdgcn_logf(x); }
__device__ __forceinline__ float frcp(float x) { return __builtin_amdgcn_rcpf(x); }
__device__ __forceinline__ float gelu_tanh(float x) { const float u = 0.7978845608028654f * (x + 0.044715f * x * x * x); return x * frcp(1.f + fexp2(-2.f * LOG2E * u)); }
__device__ __forceinline__ float sigmoidf_(float x) { return frcp(1.f + fexp2(-LOG2E * x)); }
__device__ __forceinline__ void unpack8(u32x4 w, float* f) {
    f[0] = bf2f(w.x & 0xffffu); f[1] = bf2f(w.x >> 16); f[2] = bf2f(w.y & 0xffffu); f[3] = bf2f(w.y >> 16);
    f[4] = bf2f(w.z & 0xffffu); f[5] = bf2f(w.z >> 16); f[6] = bf2f(w.w & 0xffffu); f[7] = bf2f(w.w >> 16);
}
#define MFMA32(a, b, c) __builtin_amdgcn_mfma_f32_32x32x16_bf16((a), (b), (c), 0, 0, 0)
__device__ __forceinline__ int fresh_lane() { int l; asm volatile("v_mbcnt_lo_u32_b32 %0, -1, 0\n\tv_mbcnt_hi_u32_b32 %0, -1, %0" : "=v"(l)); return l; }
__device__ __forceinline__ int fresh_tid(int wid) { return wid * 64 + fresh_lane(); }
__device__ __forceinline__ float max3f(float a, float b, float c) { float r; asm("v_max3_f32 %0, %1, %2, %3" : "=v"(r) : "v"(a), "v"(b), "v"(c)); return r; }
__device__ __forceinline__ float max2f(float a, float b) { float r; asm("v_max_f32_e32 %0, %1, %2" : "=v"(r) : "v"(a), "v"(b)); return r; }
namespace pg8 {
#define PG8_LAS __attribute__((address_space(3)))


constexpr int BM = 256, BK = 64, HALF = 128, HTB = HALF * BK * 2  , STAGE_BYTES = 8 * HTB, NXCD = 8, WGM = 8;

__host__ __device__ __forceinline__ int lds_byte(int r, int c) { const int st = (r >> 4) * 2 + (c >> 5), rr = r & 15, cc = c & 31, ob = rr * 64 + cc * 2; return st * 1024 + (ob ^ (((ob >> 9) & 1) << 5)); }
__host__ __device__ __forceinline__ void stage_rc(int b, int& R, int& C) { const int st = b / 1024, sb = b % 1024, swz = sb ^ (((sb >> 9) & 1) << 5); R = (st >> 1) * 16 + swz / 64; C = (st & 1) * 32 + (swz % 64) / 2; }
__host__ __device__ __forceinline__ int perm32(int rho) { const int n = rho >> 4, i = rho & 15; return 8 * (i >> 2) + 4 * n + (i & 3); }

struct Unit { int pm, pn; };
struct Gemm { const bf16_t* A; const bf16_t* Bt; int M, N, K, lda, ldb; };

struct StaticOrder {
    int nM, nN, nwg, G, c;
    __host__ __device__ void init(int M, int N, int G_, int c_) { nM = M / BM; nN = N / BM; nwg = nM * nN; G = G_; c = c_; }
    __host__ __device__ bool next(int i, Unit& u) const {
        const int L = i * G + c; if (L >= nwg) return false;
        int wgid = (int)L; { const int q = nwg / NXCD, r = nwg % NXCD, xcd = wgid % NXCD, off = wgid / NXCD; wgid = (xcd < r ? xcd * (q + 1) : r * (q + 1) + (xcd - r) * q) + off; }
        const int nig = WGM * nN, gid = wgid / nig, fm = gid * WGM, gsz = (nM - fm) < WGM ? (nM - fm) : WGM;
        u.pm = fm + ((wgid % nig) % gsz); u.pn = (wgid % nig) / gsz; return true;
    }
    __device__ __forceinline__ void a_ready(const Unit&) const {}
    __device__ __forceinline__ void done(const Unit&) const {}
};

template <int MODE> __device__ __forceinline__ float actf(float v) {
    if (MODE == 1) return gelu_tanh(v);
    if (MODE == 2) return v * 0.125f;
    if (MODE == 3) return sigmoidf_(v);
    if (MODE == 4) { const float r = v > 0.f ? v : 0.f; return r * r; }
    return v;
}
template <int MODE> __device__ __forceinline__ void store_tile_perm(const f32x4 (&acc)[2][2][4][2], bf16_t* base, int ld, int pm, int colt, int wr, int wc, int fr, int fq) {
    const int row0 = pm * BM + wr * 64 + fr, col0 = colt + wc * 32 + 8 * fq;
#pragma unroll
    for (int ai = 0; ai < 2; ++ai)
#pragma unroll
        for (int m = 0; m < 4; ++m) { bf16_t* rowp = base + (size_t)(row0 + ai * HALF + m * 16) * ld + col0;
#pragma unroll
            for (int bj = 0; bj < 2; ++bj) { const f32x4 v0 = acc[ai][bj][m][0], v1 = acc[ai][bj][m][1];
                u32x4 w; w.x = pk2(actf<MODE>(v0[0]), actf<MODE>(v0[1])); w.y = pk2(actf<MODE>(v0[2]), actf<MODE>(v0[3]));
                w.z = pk2(actf<MODE>(v1[0]), actf<MODE>(v1[1])); w.w = pk2(actf<MODE>(v1[2]), actf<MODE>(v1[3]));
                *(u32x4*)(rowp + bj * HALF) = w; } }
}
template <int MODE> struct EpiBf16 {
    static constexpr bool PERM = true, AFTER_DRAIN = false, KEEP_ACC = false;
    bf16_t* O; int ldc;
    __device__ __forceinline__ void operator()(const f32x4 (&acc)[2][2][4][2], const Unit& u, int wr, int wc, int fr, int fq) const { store_tile_perm<MODE>(acc, O, ldc, u.pm, u.pn * BM, wr, wc, fr, fq); }
};
struct EpiInProj {
    static constexpr bool PERM = true, AFTER_DRAIN = false, KEEP_ACC = false;
    bf16_t* ZA; bf16_t* ZG;
    __device__ __forceinline__ void operator()(const f32x4 (&acc)[2][2][4][2], const Unit& u, int wr, int wc, int fr, int fq) const {
        const int pn = u.pn;
        if (pn < 4) store_tile_perm<1>(acc, ZA, ZA_LD, u.pm, pn * BM, wr, wc, fr, fq);
        else if (pn == 12 || pn == 13) store_tile_perm<2>(acc, ZA, ZA_LD, u.pm, pn * BM, wr, wc, fr, fq);
        else if (pn < 18) store_tile_perm<0>(acc, ZA, ZA_LD, u.pm, pn * BM, wr, wc, fr, fq);
        else store_tile_perm<3>(acc, ZG, ZG_LD, u.pm, (pn - 18) * BM, wr, wc, fr, fq);
    }
};
struct EpiMlaQ {
    static constexpr bool PERM = false, AFTER_DRAIN = false, KEEP_ACC = false;
    bf16_t* QM; const float* COS; const float* SIN; float qs;
    __device__ __forceinline__ void operator()(const f32x4 (&acc)[2][2][4][2], const Unit& u, int wr, int wc, int fr, int fq) const {
        const int row0 = u.pm * BM + wr * 64 + fr;
#pragma unroll
        for (int bj = 0; bj < 2; ++bj) {
            const int g32 = 8 * u.pn + 4 * bj + wc; const bool pe = (g32 % 3) == 2; const int colb = u.pn * BM + bj * HALF + wc * 32 + 4 * fq;
            f32x4 cv[2][4], sv[2][4];
            if (pe) {
#pragma unroll
                for (int ai = 0; ai < 2; ++ai)
#pragma unroll
                    for (int m = 0; m < 4; ++m) { const size_t ro = (size_t)(row0 + ai * HALF + m * 16) * 16 + 4 * fq; cv[ai][m] = *(const f32x4*)(COS + ro); sv[ai][m] = *(const f32x4*)(SIN + ro); }
                asm volatile("" ::: "memory");
            }
#pragma unroll
            for (int ai = 0; ai < 2; ++ai)
#pragma unroll
                for (int m = 0; m < 4; ++m) { const int row = row0 + ai * HALF + m * 16;
                    f32x4 x1 = acc[ai][bj][m][0] * qs, x2 = acc[ai][bj][m][1] * qs;
                    if (pe) { const f32x4 c = cv[ai][m], s = sv[ai][m];
                        const f32x4 o1 = x1 * c - x2 * s, o2 = x2 * c + x1 * s; x1 = o1; x2 = o2; }
                    u32x2 w1, w2; w1.x = pk2(x1[0], x1[1]); w1.y = pk2(x1[2], x1[3]); w2.x = pk2(x2[0], x2[1]); w2.y = pk2(x2[2], x2[3]);
                    bf16_t* p = QM + (size_t)row * 768 + colb; *(u32x2*)p = w1; *(u32x2*)(p + 16) = w2; }
        }
    }
};
struct EpiBranch {
    static constexpr bool PERM = true, AFTER_DRAIN = false, KEEP_ACC = true;
    const bf16_t* ZG; bf16_t* MGB;
    __device__ __forceinline__ void operator()(f32x4 (&acc)[2][2][4][2], const Unit& u, int wr, int wc, int fr, int fq) const {
        const int br = u.pm >> 6, pm = u.pm & 63, pn = u.pn & 3;
        const int row0 = pm * BM + wr * 64 + fr, col0 = pn * BM + wc * 32 + 8 * fq;
        const float GMIN = 1e-30f;
#pragma unroll
        for (int ai = 0; ai < 2; ++ai) {
            u32x4 gk[4][2], gn[4][2];
#pragma unroll
            for (int m = 0; m < 4; ++m)
#pragma unroll
                for (int bj = 0; bj < 2; ++bj) { const bf16_t* gp = ZG + (size_t)(row0 + ai * HALF + m * 16) * ZG_LD + br * 1024 + col0 + bj * HALF;
                    gk[m][bj] = *(const u32x4*)gp; if (br < 3) gn[m][bj] = *(const u32x4*)(gp + 1024); }
            asm volatile("" ::: "memory");
#pragma unroll
            for (int m = 0; m < 4; ++m)
#pragma unroll
                for (int bj = 0; bj < 2; ++bj) {
                    float g[8]; unpack8(gk[m][bj], g);
#pragma unroll
                    for (int e = 0; e < 8; ++e) g[e] = g[e] > GMIN ? g[e] : GMIN;
                    if (br < 3) { float n[8]; unpack8(gn[m][bj], n);
#pragma unroll
                        for (int e = 0; e < 8; ++e) g[e] *= frcp(n[e] > GMIN ? n[e] : GMIN); }
                    f32x4 v0 = acc[ai][bj][m][0], v1 = acc[ai][bj][m][1];
                    v0[0] *= g[0]; v0[1] *= g[1]; v0[2] *= g[2]; v0[3] *= g[3]; v1[0] *= g[4]; v1[1] *= g[5]; v1[2] *= g[6]; v1[3] *= g[7];
                    if (br < 3) { acc[ai][bj][m][0] = v0; acc[ai][bj][m][1] = v1; }
                    else { u32x4 w; w.x = pk2(v0[0], v0[1]); w.y = pk2(v0[2], v0[3]); w.z = pk2(v1[0], v1[1]); w.w = pk2(v1[2], v1[3]);
                        *(u32x4*)(MGB + (size_t)(row0 + ai * HALF + m * 16) * 1024 + col0 + bj * HALF) = w;
                        acc[ai][bj][m][0] = (f32x4){0.f, 0.f, 0.f, 0.f}; acc[ai][bj][m][1] = (f32x4){0.f, 0.f, 0.f, 0.f}; }
                }
        }
    }
};
struct EpiResid {
    static constexpr bool PERM = false, AFTER_DRAIN = false, KEEP_ACC = false;
    const float* xin; float* xout; const float* gate;
    __device__ __forceinline__ void operator()(const f32x4 (&acc)[2][2][4][2], const Unit& u, int wr, int wc, int fr, int fq) const {
        const int row0 = u.pm * BM + wr * 64 + fr, col0 = u.pn * BM + wc * 32 + 4 * fq;
        const float* g = gate + (size_t)(u.pm >> 5) * 6144;
#pragma unroll
        for (int bj = 0; bj < 2; ++bj)
#pragma unroll
            for (int n = 0; n < 2; ++n) { const int col = col0 + bj * HALF + n * 16; const f32x4 gv = *(const f32x4*)(g + col);
                f32x4 xiv[2][4];
#pragma unroll
                for (int ai = 0; ai < 2; ++ai)
#pragma unroll
                    for (int m = 0; m < 4; ++m) xiv[ai][m] = *(const f32x4*)(xin + (size_t)(row0 + ai * HALF + m * 16) * 1024 + col);
                asm volatile("" ::: "memory");
#pragma unroll
                for (int ai = 0; ai < 2; ++ai)
#pragma unroll
                    for (int m = 0; m < 4; ++m) { const size_t off = (size_t)(row0 + ai * HALF + m * 16) * 1024 + col; *(f32x4*)(xout + off) = xiv[ai][m] + gv * acc[ai][bj][m][n]; } }
    }
};
struct BranchOrder {
    StaticOrder so;
    __device__ bool next(int i, Unit& u) const { Unit t; if (!so.next(i >> 2, t)) return false; const int br = i & 3; u.pm = br * 64 + t.pm; u.pn = br * 4 + t.pn; return true; }
    __device__ __forceinline__ void a_ready(const Unit&) const {}
    __device__ __forceinline__ void done(const Unit&) const {}
};

template <class Epi, class Sched, bool ALIGN_EPI = false, bool SP2 = false>
__device__ __forceinline__ void gemm_phase(PG8_LAS unsigned char* lds, const Gemm g, const Sched& S, const Epi& E, int tid_in) {
    int tid = tid_in; asm volatile("" : "+v"(tid)); float zf = 0.f; asm volatile("" : "+v"(zf));
    const int wid = __builtin_amdgcn_readfirstlane(tid >> 6), lane = tid & 63, wr = wid >> 2, wc = wid & 3, fr = lane & 15, fq = lane >> 4;
    const int K = g.K, nt = K / BK;
    unsigned voffA[2], voffB[2];
#pragma unroll
    for (int i = 0; i < 2; ++i) { int R, C; stage_rc(tid * 16 + i * 8192, R, C); const int Rb = Epi::PERM ? ((R & ~31) + perm32(R & 31)) : R;
        voffA[i] = (unsigned)(R * g.lda + C) * 2u; voffB[i] = (unsigned)(Rb * g.ldb + C) * 2u; }
    const unsigned voffA0 = voffA[0], voffB0 = voffB[0]; const unsigned p1A = 64u * (unsigned)g.lda * 2u, p1B = 64u * (unsigned)g.ldb * 2u;
    const size_t kstep = (size_t)(BK * 2);
    const size_t hstepA = (size_t)HALF * g.lda * 2, hstepB = (size_t)HALF * g.ldb * 2;
    const size_t tstepA = 2 * hstepA, tstepB = 2 * hstepB;
    const unsigned ldsw = (unsigned)wid * 1024u;
    const int aoff = lds_byte(wr * 64 + fr, fq * 8), boff = lds_byte(wc * 32 + fr, fq * 8);
#define PG8_SA(b, h) (((b) * 2 + (h)) * HTB)
#define PG8_SB(b, h) ((4 + (b) * 2 + (h)) * HTB)
#define PG8_STAGE(bufoff, gbase, voff, p1) do { _Pragma("unroll") for (int _i = 0; _i < 2; ++_i) { \
        const char* gb_ = (const char*)(gbase) + (size_t)_i * (p1); asm volatile("" : "+s"(gb_));     \
        __builtin_amdgcn_global_load_lds((const unsigned*)(gb_ + (voff)), (PG8_LAS unsigned*)(lds + (bufoff) + ldsw + _i * 8192), 16, 0, 0); } } while (0)
#define PG8_LDA(dst, b, h) do { _Pragma("unroll") for (int m = 0; m < 4; ++m) _Pragma("unroll") for (int k = 0; k < 2; ++k) dst[m][k] = *(const PG8_LAS bf16x8*)(lds + PG8_SA(b, h) + aoff + m * 2048 + k * 1024); } while (0)
#define PG8_LDB(dst, b, h) do { _Pragma("unroll") for (int n = 0; n < 2; ++n) _Pragma("unroll") for (int k = 0; k < 2; ++k) dst[n][k] = *(const PG8_LAS bf16x8*)(lds + PG8_SB(b, h) + boff + n * 2048 + k * 1024); } while (0)
#define PG8_MMA(ai, bj, At, Bt) do { __builtin_amdgcn_s_setprio(1); _Pragma("unroll") for (int m = 0; m < 4; ++m) _Pragma("unroll") for (int n = 0; n < 2; ++n) _Pragma("unroll") for (int k = 0; k < 2; ++k) \
        acc[ai][bj][m][n] = __builtin_amdgcn_mfma_f32_16x16x32_bf16(Bt[n][k], At[m][k], acc[ai][bj][m][n], 0, 0, 0); __builtin_amdgcn_s_setprio(0); } while (0)
#define PG8_WAIT_V(n) asm volatile("s_waitcnt vmcnt(" #n ")" ::: "memory")
#define PG8_WAIT_L(n) asm volatile("s_waitcnt lgkmcnt(" #n ")" ::: "memory")
#define PG8_BAR __builtin_amdgcn_s_barrier()
#define PG8_SCHED __builtin_amdgcn_sched_barrier(0)
    Unit cur, nxt; int ui = 0;
    if (!S.next(0, cur)) return;
    f32x4 acc[2][2][4][2];
#pragma unroll
    for (int a = 0; a < 2; ++a)
#pragma unroll
        for (int b = 0; b < 2; ++b)
#pragma unroll
            for (int m = 0; m < 4; ++m)
#pragma unroll
                for (int n = 0; n < 2; ++n) acc[a][b][m][n] = (f32x4){zf, zf, zf, zf};
    bf16x8 At[4][2], B0[2][2], B1[2][2];
    const char* cA = (const char*)g.A + (size_t)cur.pm * tstepA; const char* cB = (const char*)g.Bt + (size_t)cur.pn * tstepB;
    S.a_ready(cur);
    if constexpr (SP2) {
        PG8_STAGE(PG8_SB(0, 0), cB, voffB0, p1B); PG8_STAGE(PG8_SB(0, 1), cB + hstepB, voffB0, p1B); PG8_STAGE(PG8_SA(0, 0), cA, voffA0, p1A); PG8_STAGE(PG8_SA(0, 1), cA + hstepA, voffA0, p1A);
        if (wr == 1) PG8_BAR;
        PG8_WAIT_V(2); PG8_BAR;
        PG8_STAGE(PG8_SB(1, 0), cB + kstep, voffB0, p1B); PG8_STAGE(PG8_SA(1, 0), cA + kstep, voffA0, p1A); PG8_STAGE(PG8_SB(1, 1), cB + hstepB + kstep, voffB0, p1B);
        PG8_WAIT_V(6); PG8_BAR;
    } else {
        PG8_STAGE(PG8_SB(0, 0), cB, voffB0, p1B); PG8_STAGE(PG8_SA(0, 0), cA, voffA0, p1A); PG8_STAGE(PG8_SB(0, 1), cB + hstepB, voffB0, p1B); PG8_STAGE(PG8_SA(0, 1), cA + hstepA, voffA0, p1A);
        if (wr == 1) PG8_BAR;
        PG8_WAIT_V(4); PG8_BAR;
        PG8_STAGE(PG8_SB(1, 0), cB + kstep, voffB0, p1B); PG8_STAGE(PG8_SA(1, 0), cA + kstep, voffA0, p1A); PG8_STAGE(PG8_SB(1, 1), cB + hstepB + kstep, voffB0, p1B);
        PG8_WAIT_V(6); PG8_BAR;
    }
    for (;;) {
        const bool has_next = S.next(ui + 1, nxt);
        const char* nA = has_next ? (const char*)g.A + (size_t)nxt.pm * tstepA : cA; const char* nB = has_next ? (const char*)g.Bt + (size_t)nxt.pn * tstepB : cB;
        for (int t = 0; t < nt; t += 2) {
            const bool last = (t == nt - 2);
            const char* a1 = cA + (size_t)(t + 1) * kstep;
            const char* a2 = last ? nA : cA + (size_t)(t + 2) * kstep; const char* b2 = last ? nB : cB + (size_t)(t + 2) * kstep;
            const char* a3 = a2 + kstep; const char* b3 = b2 + kstep;
            if (last && has_next) S.a_ready(nxt);
            if constexpr (SP2) {
            PG8_LDB(B0, 0, 0); PG8_LDB(B1, 0, 1); PG8_SCHED; PG8_LDA(At, 0, 0); PG8_STAGE(PG8_SA(1, 1), a1 + hstepA, voffA0, p1A);
            PG8_WAIT_V(8); PG8_WAIT_L(0); PG8_BAR; PG8_MMA(0, 0, At, B0); PG8_MMA(0, 1, At, B1); PG8_BAR; PG8_SCHED;
            PG8_LDA(At, 0, 1); PG8_STAGE(PG8_SB(0, 0), b2, voffB0, p1B); PG8_STAGE(PG8_SB(0, 1), b2 + hstepB, voffB0, p1B); PG8_STAGE(PG8_SA(0, 0), a2, voffA0, p1A);
            PG8_WAIT_V(8); PG8_WAIT_L(0); PG8_BAR; PG8_MMA(1, 0, At, B0); PG8_MMA(1, 1, At, B1); PG8_BAR; PG8_SCHED;
            PG8_LDB(B0, 1, 0); PG8_LDB(B1, 1, 1); PG8_SCHED; PG8_LDA(At, 1, 0); PG8_STAGE(PG8_SA(0, 1), a2 + hstepA, voffA0, p1A);
            PG8_WAIT_V(8); PG8_WAIT_L(0); PG8_BAR; PG8_MMA(0, 0, At, B0); PG8_MMA(0, 1, At, B1); PG8_BAR; PG8_SCHED;
            PG8_LDA(At, 1, 1); PG8_STAGE(PG8_SB(1, 0), b3, voffB0, p1B); PG8_STAGE(PG8_SB(1, 1), b3 + hstepB, voffB0, p1B); PG8_STAGE(PG8_SA(1, 0), a3, voffA0, p1A);
            PG8_WAIT_V(8); PG8_WAIT_L(0); PG8_BAR; PG8_MMA(1, 0, At, B0); PG8_MMA(1, 1, At, B1); PG8_BAR; PG8_SCHED;
            } else {
            PG8_LDB(B0, 0, 0); PG8_SCHED; PG8_LDA(At, 0, 0); PG8_STAGE(PG8_SA(1, 1), a1 + hstepA, voffA0, p1A);
            PG8_WAIT_L(8); PG8_BAR; PG8_WAIT_L(0); PG8_MMA(0, 0, At, B0); PG8_BAR; PG8_SCHED;
            PG8_LDB(B1, 0, 1); PG8_STAGE(PG8_SB(0, 0), b2, voffB0, p1B);
            PG8_BAR; PG8_WAIT_L(0); PG8_MMA(0, 1, At, B1); PG8_BAR;
            PG8_LDA(At, 0, 1); PG8_STAGE(PG8_SA(0, 0), a2, voffA0, p1A);
            PG8_BAR; PG8_WAIT_L(0); PG8_MMA(1, 0, At, B0); PG8_BAR; PG8_SCHED;
            PG8_STAGE(PG8_SB(0, 1), b2 + hstepB, voffB0, p1B);
            PG8_WAIT_V(6); PG8_BAR; PG8_MMA(1, 1, At, B1); PG8_BAR;
            PG8_LDB(B0, 1, 0); PG8_SCHED; PG8_LDA(At, 1, 0); PG8_STAGE(PG8_SA(0, 1), a2 + hstepA, voffA0, p1A);
            PG8_WAIT_L(8); PG8_BAR; PG8_WAIT_L(0); PG8_MMA(0, 0, At, B0); PG8_BAR; PG8_SCHED;
            PG8_LDB(B1, 1, 1); PG8_STAGE(PG8_SB(1, 0), b3, voffB0, p1B);
            PG8_BAR; PG8_WAIT_L(0); PG8_MMA(0, 1, At, B1); PG8_BAR;
            PG8_LDA(At, 1, 1); PG8_STAGE(PG8_SA(1, 0), a3, voffA0, p1A);
            PG8_BAR; PG8_WAIT_L(0); PG8_MMA(1, 0, At, B0); PG8_BAR; PG8_SCHED;
            PG8_STAGE(PG8_SB(1, 1), b3 + hstepB, voffB0, p1B);
            PG8_WAIT_V(6); PG8_BAR; PG8_MMA(1, 1, At, B1); PG8_BAR;
            }
        }
        if constexpr (ALIGN_EPI) { if (wr == 0) PG8_BAR; }
        if constexpr (!Epi::AFTER_DRAIN) { int ln_; asm volatile("v_mbcnt_lo_u32_b32 %0, -1, 0\n\tv_mbcnt_hi_u32_b32 %0, -1, %0" : "=v"(ln_)); const int fr_ = ln_ & 15, fq_ = ln_ >> 4;
            E(acc, cur, wr, wc, fr_, fq_); S.done(cur); }
        if (!has_next) break;
        if constexpr (!Epi::KEEP_ACC) {
#pragma unroll
        for (int a = 0; a < 2; ++a)
#pragma unroll
            for (int b = 0; b < 2; ++b)
#pragma unroll
                for (int m = 0; m < 4; ++m)
#pragma unroll
                    for (int n = 0; n < 2; ++n) acc[a][b][m][n] = (f32x4){zf, zf, zf, zf};
        }
        cur = nxt; cA = nA; cB = nB; ++ui;
        if constexpr (ALIGN_EPI) { if (wr == 1) PG8_BAR; }
    }
    PG8_WAIT_V(0);
    if constexpr (!ALIGN_EPI) { if (wr == 0) PG8_BAR; }
    PG8_BAR;
    if constexpr (Epi::AFTER_DRAIN) { E.fused(acc, cur, wr, wc, fr, fq, lds, wid, lane); S.done(cur); }
#undef PG8_SA
#undef PG8_SB
#undef PG8_STAGE
#undef PG8_LDA
#undef PG8_LDB
#undef PG8_MMA
#undef PG8_WAIT_V
#undef PG8_WAIT_L
#undef PG8_BAR
#undef PG8_SCHED
}
}

struct Args { const void* in[21]; float* out; unsigned char* ws; int ph_lo, ph_hi; };
typedef const __attribute__((address_space(4))) Args* ArgP;
constexpr int NPH = 43;
__constant__ float INV_FREQ[16] = {1.0f, 0.5623413251903491f, 0.31622776601683794f, 0.1778279410038923f, 0.1f, 0.05623413251903491f, 0.03162277660168379f, 0.01778279410038923f,
                                   0.01f, 0.005623413251903491f, 0.0031622776601683794f, 0.0017782794100389228f, 0.001f, 0.0005623413251903491f, 0.00031622776601683794f, 0.00017782794100389227f};

__device__ __forceinline__ void phase_prologue(ArgP ap, int vcu, int G, int gw, int NGW, int wid, int lane, LAS unsigned char* lds) {
    const float* cvec = (const float*)ap->in[1]; const int* pos = (const int*)ap->in[2]; const float* ada_w = (const float*)ap->in[3]; const float* ada_b = (const float*)ap->in[4];
    float* MOD = (float*)(ap->ws + WS_MOD);
    LAS float* red = (LAS float*)(lds + 73728);
    for (int it = vcu; it < 4 * 96; it += G) {
        const int l = it / 96, cb = it % 96, ks = wid, col = cb * 64 + lane;
        const float* w = ada_w + ((size_t)l * 1024 + ks * 128) * 6144 + col;
        float c00 = cvec[ks * 128 + lane], c01 = cvec[ks * 128 + 64 + lane], c10 = cvec[1024 + ks * 128 + lane], c11 = cvec[1024 + ks * 128 + 64 + lane];
        c00 = c00 / (1.f + __expf(-c00)); c01 = c01 / (1.f + __expf(-c01)); c10 = c10 / (1.f + __expf(-c10)); c11 = c11 / (1.f + __expf(-c11));
        float a0 = 0.f, a1 = 0.f;
#pragma unroll 16
        for (int k = 0; k < 64; ++k) { const float wv = w[(size_t)k * 6144]; a0 += wv * rdl(c00, k); a1 += wv * rdl(c10, k); }
#pragma unroll 16
        for (int k = 0; k < 64; ++k) { const float wv = w[(size_t)(64 + k) * 6144]; a0 += wv * rdl(c01, k); a1 += wv * rdl(c11, k); }
        red[(wid * 2 + 0) * 64 + lane] = a0; red[(wid * 2 + 1) * 64 + lane] = a1;
        __syncthreads();
        if (wid < 2) { float s = ada_b[l * 6144 + col];
#pragma unroll
            for (int k8 = 0; k8 < 8; ++k8) s += red[(k8 * 2 + wid) * 64 + lane];
            MOD[((size_t)l * 2 + wid) * 6144 + col] = s; }
        __syncthreads();
    }
    float* COS = (float*)(ap->ws + WS_COS); float* SIN = (float*)(ap->ws + WS_SIN);
    for (int idx = gw * 64 + lane; idx < MT * 16; idx += NGW * 64) {
        const int row = idx >> 4, i = idx & 15;
        const float ang = (float)pos[row] * INV_FREQ[i];
        const double t = (double)ang * 0.6366197723675814; const double kq = rint(t); const double rr = (double)ang - kq * 1.5707963267948966;
        const int q = ((int)kq) & 3; const float rf = (float)rr, r2 = rf * rf;
        const float s = rf * (1.f + r2 * (-1.6666666667e-1f + r2 * (8.3333333333e-3f + r2 * (-1.9841269841e-4f + r2 * 2.7557319224e-6f))));
        const float c = 1.f + r2 * (-0.5f + r2 * (4.1666666667e-2f + r2 * (-1.3888888889e-3f + r2 * (2.4801587302e-5f + r2 * -2.7557319224e-7f))));
        COS[idx] = (q == 0) ? c : (q == 1) ? -s : (q == 2) ? -c : s;
        SIN[idx] = (q == 0) ? s : (q == 1) ? c : (q == 2) ? -s : -c;
    }
}
__device__ __forceinline__ void phase_modreduce(ArgP ap, int gw, int NGW, int lane) {
    const float* MODP = (const float*)(ap->ws + WS_H); float* MOD = (float*)(ap->ws + WS_MOD); const float* ada_b = (const float*)ap->in[4];
    for (int idx = gw * 64 + lane; idx < 4 * 2 * 6144; idx += NGW * 64) {
        const int l = idx / 12288, col = idx % 6144; float s = ada_b[l * 6144 + col];
#pragma unroll
        for (int ks = 0; ks < 8; ++ks) s += MODP[(size_t)ks * 49152 + idx];
        MOD[idx] = s;
    }
}

__device__ __forceinline__ void transpose_item(const float* W, int K, int N, bf16_t* WT, int split_at, int split_add, LAS float* scr, int item, int lane) {
    const int nblk = N / 32, kb = item / nblk, nb = item % nblk, k0 = 64 * kb, n0 = 32 * nb; const int row_off = (n0 >= split_at) ? split_add : 0;
    { f32x4 v[8]; const int c4 = (lane & 7) * 4;
#pragma unroll
      for (int i = 0; i < 8; ++i) v[i] = *(const f32x4*)(W + (size_t)(k0 + 8 * i + (lane >> 3)) * N + n0 + c4);
#pragma unroll
      for (int i = 0; i < 8; ++i) { LAS float* d = scr + (8 * i + (lane >> 3)) * 33 + c4; d[0] = v[i][0]; d[1] = v[i][1]; d[2] = v[i][2]; d[3] = v[i][3]; } }
    asm volatile("s_waitcnt lgkmcnt(0)" ::: "memory");
    const int c = lane & 7;
#pragma unroll
    for (int j = 0; j < 4; ++j) { const int n = (lane >> 3) + 8 * j; const LAS float* s = scr + (8 * c) * 33 + n;
        u32x4 o; o.x = pk2(s[0 * 33], s[1 * 33]); o.y = pk2(s[2 * 33], s[3 * 33]); o.z = pk2(s[4 * 33], s[5 * 33]); o.w = pk2(s[6 * 33], s[7 * 33]);
        *(u32x4*)(WT + (size_t)(row_off + n0 + n) * K + k0 + 8 * c) = o; }
    asm volatile("s_waitcnt lgkmcnt(0)" ::: "memory");
}
__device__ __forceinline__ void convert_weights(ArgP ap, int l, int which, LAS unsigned char* lds, int gw, int NGW, int wid, int lane) {
    LAS float* scr = (LAS float*)(lds + wid * 8704);
    unsigned char* ws = ap->ws;
    constexpr int I_IN = 16 * 269, I_UQ = 4 * 24, I_UKV = 2 * 32, I_BR = 8 * 32, I_OUT = 16 * 32, I_1 = 16 * 128, I_2 = 64 * 32;
    constexpr int I_REST = I_UQ + I_UKV + 4 * I_BR + I_OUT + I_1 + I_2;
    const int BIG = 1 << 30;
    if (which & 1) {
        const float* w_in = (const float*)ap->in[7] + (size_t)l * 1024 * IN_COLS;
        for (int it = gw; it < I_IN; it += NGW) transpose_item(w_in, 1024, IN_COLS, (bf16_t*)(ws + WS_WIN), 2976, 96, scr, it, lane);
        bf16_t* wt = (bf16_t*)(ws + WS_WIN) + (size_t)2976 * 1024; unsigned z = 0u; asm volatile("" : "+v"(z));
        for (int idx = gw * 64 + lane; idx < 96 * 1024 / 8; idx += NGW * 64) *(u32x4*)(wt + (size_t)idx * 8) = (u32x4){z, z, z, z};
    }
    if (which & 2) {
        { const float* sg_w = (const float*)ap->in[9] + (size_t)l * 4 * 128 * 128; bf16_t* o = (bf16_t*)(ws + WS_SGW);
          for (int idx = gw * 64 + lane; idx < 4 * 128 * 128; idx += NGW * 64) { const int t = (idx >> 7) & 127, s = idx & 127; o[idx] = (s <= t) ? f2bf(sg_w[idx]) : (bf16_t)0; } }
        const float* w_uq = (const float*)ap->in[13] + (size_t)l * 256 * 768;
        const float* w_ukv = (const float*)ap->in[15] + (size_t)l * 128 * 1024;
        const float* w_br = (const float*)ap->in[16] + (size_t)l * 4 * 512 * 1024;
        const float* w_out = (const float*)ap->in[17] + (size_t)l * 1024 * 1024;
        const float* w1 = (const float*)ap->in[18] + (size_t)l * 1024 * 4096;
        const float* w2 = (const float*)ap->in[19] + (size_t)l * 4096 * 1024;
        for (int it = gw; it < I_REST; it += NGW) {
            int r = it;
            if (r < I_UQ) { transpose_item(w_uq, 256, 768, (bf16_t*)(ws + WS_WUQ), BIG, 0, scr, r, lane); continue; } r -= I_UQ;
            if (r < I_UKV) { transpose_item(w_ukv, 128, 1024, (bf16_t*)(ws + WS_WUKV), BIG, 0, scr, r, lane); continue; } r -= I_UKV;
            if (r < 4 * I_BR) { const int n = r / I_BR; transpose_item(w_br + (size_t)n * 512 * 1024, 512, 1024, (bf16_t*)(ws + WS_WBR) + (size_t)n * 1024 * 512, BIG, 0, scr, r % I_BR, lane); continue; } r -= 4 * I_BR;
            if (r < I_OUT) { transpose_item(w_out, 1024, 1024, (bf16_t*)(ws + WS_WOUT), BIG, 0, scr, r, lane); continue; } r -= I_OUT;
            if (r < I_1) { transpose_item(w1, 1024, 4096, (bf16_t*)(ws + WS_W1), BIG, 0, scr, r, lane); continue; } r -= I_1;
            transpose_item(w2, 4096, 1024, (bf16_t*)(ws + WS_W2), BIG, 0, scr, r, lane);
        }
    }
}

template <int MODE> __device__ __forceinline__ void norm_row(const float* xrow, const float* g, const float* sc, const float* sh, bf16_t* orow, float* frow, int lane) {
    f32x4 v[4]; float ss = 0.f;
#pragma unroll
    for (int j = 0; j < 4; ++j) { v[j] = ((const f32x4*)xrow)[lane + 64 * j]; ss += (v[j][0] * v[j][0] + v[j][1] * v[j][1]) + (v[j][2] * v[j][2] + v[j][3] * v[j][3]); }
    const float rstd = 1.0f / sqrtf(wave_sum(ss, lane) * (1.f / 1024.f) + NORM_EPS);
#pragma unroll
    for (int j = 0; j < 4; ++j) { const int col = 4 * lane + 256 * j; const f32x4 gv = *(const f32x4*)(g + col);
        if (MODE == 0) { const f32x4 scv = *(const f32x4*)(sc + col), shv = *(const f32x4*)(sh + col); const f32x4 o = (v[j] * rstd) * gv * (1.f + scv) + shv;
            u32x2 w; w.x = pk2(o[0], o[1]); w.y = pk2(o[2], o[3]); *(u32x2*)(orow + col) = w; }
        else { *(f32x4*)(frow + col) = (v[j] * rstd) * gv; } }
}
__device__ __forceinline__ void phase_norm(const float* x, const float* g, const float* mod_l  , int sc_off, int sh_off, bf16_t* H, int gw, int NGW, int MT, int lane) {
    f32x4 v[4], vn[4];
    if (gw < MT) {
#pragma unroll
        for (int j = 0; j < 4; ++j) v[j] = ((const f32x4*)(x + (size_t)gw * 1024))[lane + 64 * j]; }
    for (int m = gw; m < MT; m += NGW) {
        const int mnx = m + NGW;
        if (mnx < MT) {
#pragma unroll
            for (int j = 0; j < 4; ++j) vn[j] = ((const f32x4*)(x + (size_t)mnx * 1024))[lane + 64 * j]; }
        const float* mb = mod_l + (size_t)(m >> 13) * 6144; bf16_t* orow = H + (size_t)m * 1024;
        f32x4 gv[4], scv[4], shv[4];
#pragma unroll
        for (int j = 0; j < 4; ++j) { const int col = 4 * lane + 256 * j; gv[j] = *(const f32x4*)(g + col); scv[j] = *(const f32x4*)(mb + sc_off + col); shv[j] = *(const f32x4*)(mb + sh_off + col); }
        float ss = 0.f;
#pragma unroll
        for (int j = 0; j < 4; ++j) ss += (v[j][0] * v[j][0] + v[j][1] * v[j][1]) + (v[j][2] * v[j][2] + v[j][3] * v[j][3]);
        const float rstd = 1.0f / sqrtf(wave_sum(ss, lane) * (1.f / 1024.f) + NORM_EPS);
#pragma unroll
        for (int j = 0; j < 4; ++j) { const int col = 4 * lane + 256 * j; const f32x4 o = (v[j] * rstd) * gv[j] * (1.f + scv[j]) + shv[j];
            u32x2 w; w.x = pk2(o[0], o[1]); w.y = pk2(o[2], o[3]); *(u32x2*)(orow + col) = w; }
#pragma unroll
        for (int j = 0; j < 4; ++j) v[j] = vn[j];
    }
}

__device__ __forceinline__ s16x4 vtr(const LAS unsigned char* p) { return __builtin_bit_cast(s16x4, __builtin_amdgcn_ds_read_tr16_b64_v4i16((LAS s16x4*)p)); }
__device__ __forceinline__ void sg_unit(int n, int g, const bf16_t* __restrict__ ZA, const bf16_t* __restrict__ SGW, const float* __restrict__ sgn_g, const float* __restrict__ sg_b, bf16_t* __restrict__ Y0,
                                        LAS unsigned char* lds, int tid) {
    const int lane = tid & 63, l31 = lane & 31, hi = lane >> 5, wid = __builtin_amdgcn_readfirstlane(tid >> 6);
    LAS f32x2* stat = (LAS f32x2*)lds; LAS bf16_t* vnT = (LAS bf16_t*)(lds + 1024);
    const int R0 = n * 128;
    { const int s = tid >> 2, cq = tid & 3; const bf16_t* vp = ZA + (size_t)(R0 + s) * ZA_LD + ZA_SGV + cq * 128;
      u32x4 w[16]; float sum = 0.f;
#pragma unroll
      for (int j = 0; j < 16; ++j) w[j] = *(const u32x4*)(vp + 8 * j);
#pragma unroll
      for (int j = 0; j < 16; ++j) { float f[8]; unpack8(w[j], f);
#pragma unroll
          for (int e = 0; e < 8; ++e) sum += f[e]; }
      sum += shx(sum, 1, lane); sum += shx(sum, 2, lane);
      const float mean = sum * (1.f / 512.f); float q = 0.f;
#pragma unroll
      for (int j = 0; j < 16; ++j) { float f[8]; unpack8(w[j], f);
#pragma unroll
          for (int e = 0; e < 8; ++e) { const float d = f[e] - mean; q += d * d; } }
      q += shx(q, 1, lane); q += shx(q, 2, lane);
      if (cq == 0) stat[s] = (f32x2){mean, 1.0f / sqrtf(q * (1.f / 512.f) + NORM_EPS)}; }
    __syncthreads();
    { const int s = tid >> 2, cq = tid & 3; const f32x2 st = stat[s];
#pragma unroll
      for (int j = 0; j < 4; ++j) { const int c = cq * 32 + 8 * j; const u32x4 w = *(const u32x4*)(ZA + (size_t)(R0 + s) * ZA_LD + ZA_SGV + g * 128 + c); float f[8]; unpack8(w, f);
          const f32x4 g0 = *(const f32x4*)(sgn_g + g * 128 + c), g1 = *(const f32x4*)(sgn_g + g * 128 + c + 4);
          u32x4 o; o.x = pk2((f[0] - st.x) * st.y * g0[0], (f[1] - st.x) * st.y * g0[1]); o.y = pk2((f[2] - st.x) * st.y * g0[2], (f[3] - st.x) * st.y * g0[3]);
          o.z = pk2((f[4] - st.x) * st.y * g1[0], (f[5] - st.x) * st.y * g1[1]); o.w = pk2((f[6] - st.x) * st.y * g1[2], (f[7] - st.x) * st.y * g1[3]);
          *(LAS u32x4*)((LAS unsigned char*)vnT + cq * 8192 + s * 64 + 16 * j) = o; } }
    __syncthreads();
    const int tb = wid & 3, cb = wid >> 2;
    f32x16 acc0 = {}, acc1 = {};
    const bf16_t* Wg = SGW + (size_t)(g * 128 + 32 * tb + l31) * 128 + 8 * hi;
    const LAS unsigned char* trp = (const LAS unsigned char*)vnT + (2 * cb) * 8192 + (8 * hi + ((lane & 15) >> 2)) * 64 + ((lane >> 4) & 1) * 32 + (lane & 3) * 8;
    bf16x8 Af[8];
#pragma unroll
    for (int ks = 0; ks < 8; ++ks) Af[ks] = *(const bf16x8*)(Wg + 16 * ks);
    float uv0[16], uv1[16], bsv[16];
#pragma unroll
    for (int r = 0; r < 16; ++r) { const int t = 32 * tb + crow(r, hi); const size_t zo = (size_t)(R0 + t) * ZA_LD + ZA_SGU + g * 128 + 64 * cb + l31;
        uv0[r] = bf2f(ZA[zo]); uv1[r] = bf2f(ZA[zo + 32]); bsv[r] = sg_b[g * 128 + t]; }
#pragma unroll
    for (int ks = 0; ks < 8; ++ks) {
        const s16x4 b0l = vtr(trp + ks * 1024), b0h = vtr(trp + ks * 1024 + 256), b1l = vtr(trp + 8192 + ks * 1024), b1h = vtr(trp + 8192 + ks * 1024 + 256);
        const bf16x8 B0 = __builtin_shufflevector(b0l, b0h, 0, 1, 2, 3, 4, 5, 6, 7), B1 = __builtin_shufflevector(b1l, b1h, 0, 1, 2, 3, 4, 5, 6, 7);
        acc0 = MFMA32(Af[ks], B0, acc0); acc1 = MFMA32(Af[ks], B1, acc1);
    }
#pragma unroll
    for (int r = 0; r < 16; ++r) { const int t = 32 * tb + crow(r, hi), row = R0 + t; const int c = g * 128 + 64 * cb + l31;
        Y0[(size_t)row * 512 + c] = f2bf(uv0[r] * (acc0[r] + bsv[r])); Y0[(size_t)row * 512 + c + 32] = f2bf(uv1[r] * (acc1[r] + bsv[r])); }
    __syncthreads();
}
__device__ __forceinline__ void conv_item(int item, const bf16_t* __restrict__ ZA, const float* __restrict__ cw  , bf16_t* __restrict__ Y1, int tid) {
    const int idx = item * 512 + tid, row = idx >> 6, c = (idx & 63) * 8, s = row & (SEQ - 1);
    float gb[8], acc[8]; unpack8(*(const u32x4*)(ZA + (size_t)row * ZA_LD + ZA_CB + c), gb);
#pragma unroll
    for (int e = 0; e < 8; ++e) acc[e] = 0.f;
#pragma unroll
    for (int k = 0; k < 3; ++k) { const int d = 2 - k; if (s - d >= 0) { const size_t rr = (size_t)(row - d) * ZA_LD; float gc[8], xv[8]; unpack8(*(const u32x4*)(ZA + rr + ZA_CC + c), gc); unpack8(*(const u32x4*)(ZA + rr + ZA_CX + c), xv);
#pragma unroll
            for (int e = 0; e < 8; ++e) acc[e] += cw[k * 512 + c + e] * (gc[e] * xv[e]); } }
    u32x4 o; o.x = pk2(gb[0] * acc[0], gb[1] * acc[1]); o.y = pk2(gb[2] * acc[2], gb[3] * acc[3]); o.z = pk2(gb[4] * acc[4], gb[5] * acc[5]); o.w = pk2(gb[6] * acc[6], gb[7] * acc[7]);
    *(u32x4*)(Y1 + (size_t)row * 512 + c) = o;
}
__device__ __forceinline__ void mlaprep_row(int row, const bf16_t* __restrict__ ZA, const float* __restrict__ gq, const float* __restrict__ gkv, const float* __restrict__ COS, const float* __restrict__ SIN,
                                            bf16_t* __restrict__ CQN, bf16_t* __restrict__ CKVN, bf16_t* __restrict__ KPE, int lane) {
    const bf16_t* z = ZA + (size_t)row * ZA_LD;
    const u32x2 wq = *(const u32x2*)(z + ZA_CQ + 4 * lane); const unsigned wkv = *(const unsigned*)(z + ZA_CKV + 2 * lane);
    const f32x4 g4 = *(const f32x4*)(gq + 4 * lane); const float gk0 = gkv[2 * lane], gk1 = gkv[2 * lane + 1];
    const int l16 = lane & 15; const float x1 = bf2f(z[ZA_KPE + l16]), x2 = bf2f(z[ZA_KPE + 16 + l16]); const float c = COS[(size_t)row * 16 + l16], s = SIN[(size_t)row * 16 + l16];
    { const float f0 = bf2f(wq.x & 0xffffu), f1 = bf2f(wq.x >> 16), f2 = bf2f(wq.y & 0xffffu), f3 = bf2f(wq.y >> 16);
      const float rstd = 1.0f / sqrtf(wave_sum((f0 * f0 + f1 * f1) + (f2 * f2 + f3 * f3), lane) * (1.f / 256.f) + NORM_EPS);
      u32x2 o; o.x = pk2(f0 * rstd * g4[0], f1 * rstd * g4[1]); o.y = pk2(f2 * rstd * g4[2], f3 * rstd * g4[3]); *(u32x2*)(CQN + (size_t)row * 256 + 4 * lane) = o; }
    { const float f0 = bf2f(wkv & 0xffffu), f1 = bf2f(wkv >> 16);
      const float rstd = 1.0f / sqrtf(wave_sum(f0 * f0 + f1 * f1, lane) * (1.f / 128.f) + NORM_EPS);
      *(unsigned*)(CKVN + (size_t)row * 128 + 2 * lane) = pk2(f0 * rstd * gk0, f1 * rstd * gk1); }
    if (lane < 16) { KPE[(size_t)row * 32 + lane] = f2bf(x1 * c - x2 * s); KPE[(size_t)row * 32 + 16 + lane] = f2bf(x2 * c + x1 * s); }
}

__device__ __forceinline__ bf16x8 pack8(const f32x16& x, int b) {
    u32x4 p; p.x = pk2(x[b], x[b + 1]); p.y = pk2(x[b + 2], x[b + 3]); p.z = pk2(x[b + 4], x[b + 5]); p.w = pk2(x[b + 6], x[b + 7]); return __builtin_bit_cast(bf16x8, p);
}
#define PV_STEP(O0_, O1_, pf_, vtp_) do { s16x4 vl_[8], vh_[8]; \
        _Pragma("unroll") for (int ks_ = 0; ks_ < 4; ++ks_) { vl_[ks_] = vtr((vtp_) + ks_ * 1024); vh_[ks_] = vtr((vtp_) + ks_ * 1024 + 512); vl_[4 + ks_] = vtr((vtp_) + 4096 + ks_ * 1024); vh_[4 + ks_] = vtr((vtp_) + 4096 + ks_ * 1024 + 512); } \
        __builtin_amdgcn_sched_barrier(0); \
        _Pragma("unroll") for (int ks_ = 0; ks_ < 4; ++ks_) { \
        const bf16x8 v0_ = __builtin_shufflevector(vl_[ks_], vh_[ks_], 0, 1, 2, 3, 4, 5, 6, 7), v1_ = __builtin_shufflevector(vl_[4 + ks_], vh_[4 + ks_], 0, 1, 2, 3, 4, 5, 6, 7); \
        O0_ = MFMA32((pf_)[ks_], v0_, O0_); O1_ = MFMA32((pf_)[ks_], v1_, O1_); } } while (0)

__device__ __forceinline__ void mla_unit(int b, int h, int qb, const bf16_t* __restrict__ QM, const bf16_t* __restrict__ KVM, const bf16_t* __restrict__ KPE, bf16_t* __restrict__ YO, LAS unsigned char* lds, int tid) {
    const int lane = tid & 63, l31 = lane & 31, hi = lane >> 5, wid = __builtin_amdgcn_readfirstlane(tid >> 6);
    const int rowbase = b * SEQ, q0 = qb * 256, qw0 = q0 + 32 * wid, qrow = qw0 + l31;
    constexpr int MLA_BUF = 22528;
    LAS unsigned char* KS = lds; LAS unsigned char* VS = lds + 14336; LAS float* wsf = (LAS float*)(lds + 2 * MLA_BUF) + wid * 64;
    bf16x8 qf[6];
    { const bf16_t* qp = QM + (size_t)(rowbase + qrow) * 768 + 96 * h + 8 * hi;
#pragma unroll
      for (int d0 = 0; d0 < 6; ++d0) qf[d0] = *(const bf16x8*)(qp + 16 * d0); }
    const int krA = tid / 12, kpA = tid % 12, krB = (tid + 512) / 12, kpB = (tid + 512) % 12, vr = tid >> 3, vp = tid & 7;
    const bf16_t* srcA = (kpA < 8) ? KVM + (size_t)(rowbase + krA) * 1024 + 128 * h + 8 * kpA : KPE + (size_t)(rowbase + krA) * 32 + 8 * (kpA - 8);
    const bf16_t* srcB = (kpB < 8) ? KVM + (size_t)(rowbase + krB) * 1024 + 128 * h + 8 * kpB : KPE + (size_t)(rowbase + krB) * 32 + 8 * (kpB - 8);
    const size_t stA = (kpA < 8) ? 64 * 1024 : 64 * 32, stB = (kpB < 8) ? 64 * 1024 : 64 * 32;
    const bf16_t* srcV = KVM + (size_t)(rowbase + vr) * 1024 + 128 * h + 64 + 8 * vp;
    LAS unsigned char* dstA = KS + krA * 224 + kpA * 16; LAS unsigned char* dstB = KS + krB * 224 + kpB * 16; LAS unsigned char* dstV = VS + (vp >> 2) * 4096 + vr * 64 + (vp & 3) * 16;
    const LAS unsigned char* kfp = KS + l31 * 224 + 16 * hi;
    const LAS unsigned char* vtp = VS + ((lane >> 4) & 1) * 32 + (lane & 3) * 8 + (4 * hi + ((lane & 15) >> 2)) * 64;
    const int NT = 4 * qb + 4;
    float m = 0.f, l = 0.f; f32x16 O0 = {}, O1 = {};
    f32x16 negm = {};
    u32x4 ka, kb = {0u, 0u, 0u, 0u}, vv;
    ka = *(const u32x4*)srcA; if (tid < 256) kb = *(const u32x4*)srcB; vv = *(const u32x4*)srcV;
    *(LAS u32x4*)dstA = ka; if (tid < 256) *(LAS u32x4*)dstB = kb; *(LAS u32x4*)dstV = vv;
    { ka = *(const u32x4*)(srcA + stA); if (tid < 256) kb = *(const u32x4*)(srcB + stB); vv = *(const u32x4*)(srcV + (size_t)64 * 1024); }
    for (int t = 0; t < NT; ++t) {
        const int cur = (t & 1) * MLA_BUF, nxt = MLA_BUF - cur;
        __syncthreads();
        if (t + 1 < NT) { *(LAS u32x4*)(dstA + nxt) = ka; if (tid < 256) *(LAS u32x4*)(dstB + nxt) = kb; *(LAS u32x4*)(dstV + nxt) = vv; }
        if (t + 2 < NT) { ka = *(const u32x4*)(srcA + (size_t)(t + 2) * stA); if (tid < 256) kb = *(const u32x4*)(srcB + (size_t)(t + 2) * stB); vv = *(const u32x4*)(srcV + (size_t)(t + 2) * 64 * 1024); }
        if (64 * t <= qw0 + 31) {
            f32x16 S0, S1;
#pragma unroll
            for (int d0 = 0; d0 < 6; ++d0) { const bf16x8 k0 = *(const LAS bf16x8*)(kfp + cur + 32 * d0), k1 = *(const LAS bf16x8*)(kfp + cur + 32 * 224 + 32 * d0);
                S0 = MFMA32(k0, qf[d0], d0 == 0 ? negm : S0); S1 = MFMA32(k1, qf[d0], d0 == 0 ? negm : S1); }
            if (64 * t + 63 > qw0) {
#pragma unroll
                for (int r = 0; r < 16; ++r) { const int kv = 64 * t + crow(r, hi); if (kv > qrow) S0[r] = -INFINITY; if (kv + 32 > qrow) S1[r] = -INFINITY; }
            }
            float mxa = max3f(S0[0], S0[1], S1[0]), mxb = max3f(S0[2], S0[3], S1[1]); mxa = max3f(mxa, S1[2], S1[3]);
#pragma unroll
            for (int r = 4; r < 16; r += 4) { mxa = max3f(mxa, S0[r], S0[r + 1]); mxb = max3f(mxb, S0[r + 2], S0[r + 3]); mxa = max3f(mxa, S1[r], S1[r + 1]); mxb = max3f(mxb, S1[r + 2], S1[r + 3]); }
            float mx = max2f(mxa, mxb);
            mx = max2f(mx, shx(mx, 32, lane));
            if (t == 0 || __any(mx > 0.f)) {
                const float d = (t == 0) ? mx : max2f(mx, 0.f);
#pragma unroll
                for (int r = 0; r < 16; ++r) { S0[r] -= d; S1[r] -= d; }
                m += d;
#pragma unroll
                for (int r = 0; r < 16; ++r) negm[r] = -m;
                if (t > 0) { const float alpha = fexp2(-d); l *= alpha;
                    if (hi == 0) wsf[l31] = alpha;
#pragma unroll
                    for (int r = 0; r < 16; ++r) { const float al = wsf[crow(r, hi)]; O0[r] *= al; O1[r] *= al; } }
            }
            float ps = 0.f;
#pragma unroll
            for (int r = 0; r < 16; ++r) { S0[r] = fexp2(S0[r]); S1[r] = fexp2(S1[r]); ps += S0[r] + S1[r]; }
            l += ps;
            bf16x8 pf[4]; pf[0] = pack8(S0, 0); pf[1] = pack8(S0, 8); pf[2] = pack8(S1, 0); pf[3] = pack8(S1, 8);
            const LAS unsigned char* vt = vtp + cur;
            PV_STEP(O0, O1, pf, vt);
        }
    }
    const float lt = l + shx(l, 32, lane);
    if (hi == 0) wsf[l31] = 1.0f / lt;
#pragma unroll
    for (int r = 0; r < 16; ++r) { const float inv = wsf[crow(r, hi)]; bf16_t* o = YO + (size_t)(rowbase + qw0 + crow(r, hi)) * 512 + 64 * h + l31; o[0] = f2bf(O0[r] * inv); o[32] = f2bf(O1[r] * inv); }
    __syncthreads();
}

__device__ __forceinline__ void sb_unit(int b, int h, int qb, const bf16_t* __restrict__ ZA, bf16_t* __restrict__ YO, LAS unsigned char* lds, int tid) {
    const int lane = tid & 63, l31 = lane & 31, hi = lane >> 5, wid = __builtin_amdgcn_readfirstlane(tid >> 6);
    const int rowbase = b * SEQ, q0 = qb * 256, qw0 = q0 + 32 * wid, qrow = qw0 + l31;
    LAS unsigned char* KS = lds; LAS unsigned char* VS = lds + 9216; volatile LAS int* flags = (volatile LAS int*)(lds + 17408);
    bf16x8 qf[4];
    { const bf16_t* qp = ZA + (size_t)(rowbase + qrow) * ZA_LD + ZA_SBQ + 64 * h + 8 * hi;
#pragma unroll
      for (int d0 = 0; d0 < 4; ++d0) qf[d0] = *(const bf16x8*)(qp + 16 * d0); }
    const int vr = tid >> 3, vp = tid & 7;
    const bf16_t* srcK = ZA + (size_t)(rowbase + vr) * ZA_LD + ZA_SBK + 64 * h + 8 * vp; const bf16_t* srcV = srcK + (ZA_SBV - ZA_SBK);
    LAS unsigned char* dstK = KS + vr * 144 + vp * 16; LAS unsigned char* dstV = VS + (vp >> 2) * 4096 + vr * 64 + (vp & 3) * 16;
    const LAS unsigned char* kfp = KS + l31 * 144 + 16 * hi;
    const LAS unsigned char* vtp = VS + ((lane >> 4) & 1) * 32 + (lane & 3) * 8 + (4 * hi + ((lane & 15) >> 2)) * 64;
    bf16x8 tri0, tri1, ones;
#pragma unroll
    for (int j = 0; j < 8; ++j) { const int k0 = 8 * (j >> 2) + 4 * hi + (j & 3); tri0[j] = (k0 > l31) ? (short)0x3F80 : (short)0; tri1[j] = (16 + k0 > l31) ? (short)0x3F80 : (short)0; ones[j] = (short)0x3F80; }
    const int NT = 4 * qb + 4;
    float R = 0.f; f32x16 O0 = {}, O1 = {};
    if (tid < 8) flags[tid] = 0;
    int done = 0;
    u32x4 kk, vv;
    kk = *(const u32x4*)(srcK + (size_t)(NT - 1) * 64 * ZA_LD); vv = *(const u32x4*)(srcV + (size_t)(NT - 1) * 64 * ZA_LD);
    for (int t = NT - 1; t >= 0; --t) {
        __syncthreads();
        { int f = 1;
#pragma unroll
          for (int i = 0; i < 8; ++i) f &= flags[i];
          if (f) break; }
        *(LAS u32x4*)dstK = kk; *(LAS u32x4*)dstV = vv;
        __syncthreads();
        if (t > 0) { kk = *(const u32x4*)(srcK + (size_t)(t - 1) * 64 * ZA_LD); vv = *(const u32x4*)(srcV + (size_t)(t - 1) * 64 * ZA_LD); }
        if (64 * t < qw0 + 31 && !done) {
            f32x16 S0 = {}, S1 = {};
            bf16x8 kf0[4], kf1[4];
#pragma unroll
            for (int d0 = 0; d0 < 4; ++d0) { kf0[d0] = *(const LAS bf16x8*)(kfp + 32 * d0); kf1[d0] = *(const LAS bf16x8*)(kfp + 32 * 144 + 32 * d0); }
            __builtin_amdgcn_sched_barrier(0);
#pragma unroll
            for (int d0 = 0; d0 < 4; ++d0) { S0 = MFMA32(kf0[d0], qf[d0], S0); S1 = MFMA32(kf1[d0], qf[d0], S1); }
            const bool diag = (64 * t + 63 >= qw0);
            f32x16 X0, X1;
#pragma unroll
            for (int r = 0; r < 16; ++r) {
                const int kv = 64 * t + crow(r, hi);
                { const float z = S0[r]; const float sp = fmaxf(z, 0.f) + LN2 * flog2(1.f + fexp2(-LOG2E * fabsf(z))); const bool ok = !diag || (kv < qrow); X0[r] = ok ? -sp : 0.f; S0[r] = ok ? (z - sp) : -INFINITY; }
                { const float z = S1[r]; const float sp = fmaxf(z, 0.f) + LN2 * flog2(1.f + fexp2(-LOG2E * fabsf(z))); const bool ok = !diag || (kv + 32 < qrow); X1[r] = ok ? -sp : 0.f; S1[r] = ok ? (z - sp) : -INFINITY; }
            }
            bf16x8 xb[4]; xb[0] = pack8(X0, 0); xb[1] = pack8(X0, 8); xb[2] = pack8(X1, 0); xb[3] = pack8(X1, 8);
            f32x16 Rv;
#pragma unroll
            for (int r = 0; r < 16; ++r) Rv[r] = R;
            f32x16 Y0 = MFMA32(tri0, xb[0], Rv); Y0 = MFMA32(tri1, xb[1], Y0); Y0 = MFMA32(ones, xb[2], Y0); Y0 = MFMA32(ones, xb[3], Y0);
            f32x16 Y1 = MFMA32(tri0, xb[2], Rv); Y1 = MFMA32(tri1, xb[3], Y1);
            const float Rn = Y0[0] + X0[0];
            R = shl(Rn, l31);
#pragma unroll
            for (int r = 0; r < 16; ++r) { S0[r] = fexp2(LOG2E * (S0[r] + Y0[r])); S1[r] = fexp2(LOG2E * (S1[r] + Y1[r])); }
            bf16x8 pf[4]; pf[0] = pack8(S0, 0); pf[1] = pack8(S0, 8); pf[2] = pack8(S1, 0); pf[3] = pack8(S1, 8);
            PV_STEP(O0, O1, pf, vtp);
            done = __all(R < -104.f);
        }
        if (lane == 0) flags[wid] = done;
    }
#pragma unroll
    for (int r = 0; r < 16; ++r) { bf16_t* o = YO + (size_t)(rowbase + qw0 + crow(r, hi)) * 512 + 64 * h + l31; o[0] = f2bf(O0[r]); o[32] = f2bf(O1[r]); }
    __syncthreads();
}
#define XB_TMO      128
#define XB_XCNT(j)  (256  + 64 * (j))
#define XB_XSUB(j)  (1280 + 64 * (j))
#define XB_XGEN(j)  (2304 + 64 * (j))
#define XB_TOP      3328
#define XB_TOPGEN   3392
#define XCD_BAR_WORDS 3456
#define XB_SPIN_CAP (1u << 18)

__device__ __forceinline__ unsigned xb_ld(unsigned* p)              { return __hip_atomic_load(p, __ATOMIC_RELAXED, __HIP_MEMORY_SCOPE_AGENT); }
__device__ __forceinline__ unsigned xb_add(unsigned* p, unsigned v) { return __hip_atomic_fetch_add(p, v, __ATOMIC_RELAXED, __HIP_MEMORY_SCOPE_AGENT); }
__device__ __forceinline__ unsigned xb_xcc_id() { return (unsigned)__builtin_amdgcn_s_getreg((3 << 11) | 20) & 0xFu; }
#define XB_SPIN(cond, bar) do { unsigned _sp = 0; while (cond) { __builtin_amdgcn_s_sleep(1); \
    if ((++_sp & 255u) == 0u) { if (xb_ld(&(bar)[XB_TMO])) break; if (_sp > XB_SPIN_CAP) { atomicAdd(&(bar)[XB_TMO], 1u); break; } } } } while (0)

struct XcdBarrier {
    unsigned* bar; unsigned x;
    volatile LAS unsigned* st;
};

__device__ __forceinline__ XcdBarrier xcd_barrier_post(unsigned* bar, volatile LAS unsigned* st) {
    XcdBarrier b; b.bar = bar; b.x = xb_xcc_id(); b.st = st;
    if (threadIdx.x == 0) st[2] = xb_add(&bar[XB_XCNT(b.x)], 1u);
    return b;
}
__device__ __forceinline__ void xcd_barrier_complete(unsigned* bar, unsigned x, unsigned& nloc, unsigned& nx) {
    const unsigned G = gridDim.x * gridDim.y * gridDim.z;
    unsigned sum, cnt, mine, sp = 0u;
    for (;;) {
        sum = 0u; cnt = 0u; mine = 0u;
#pragma unroll
        for (unsigned j = 0; j < 16; ++j) { const unsigned c = xb_ld(&bar[XB_XCNT(j)]); sum += c; cnt += (c > 0u) ? 1u : 0u; mine = (j == x) ? c : mine; }
        if (sum == G) break;
        __builtin_amdgcn_s_sleep(1);
        if ((++sp & 255u) == 0u) { if (xb_ld(&bar[XB_TMO])) break; if (sp > XB_SPIN_CAP) { atomicAdd(&bar[XB_TMO], 1u); break; } }
    }
    nloc = mine > 0u ? mine : 1u; nx = cnt > 0u ? cnt : 1u;
}

__device__ __forceinline__ void xcd_barrier(const XcdBarrier& b) {
    asm volatile("s_waitcnt vmcnt(0)" ::: "memory");
    __syncthreads();
    if (threadIdx.x == 0) {
        unsigned* bar = b.bar;
        __builtin_amdgcn_s_waitcnt(0);
        unsigned nloc = b.st[0], nx = b.st[1];
        if (nloc == 0u) { xcd_barrier_complete(bar, b.x, nloc, nx); b.st[0] = nloc; b.st[1] = nx; }
        const unsigned old = xb_add(&bar[XB_XSUB(b.x)], 1u);
        const unsigned gen = old / nloc;
        if (old + 1u == (gen + 1u) * nloc) {
            __builtin_amdgcn_fence(__ATOMIC_RELEASE, "agent");
            asm volatile("s_waitcnt vmcnt(0)" ::: "memory");
            const unsigned og = xb_add(&bar[XB_TOP], 1u);
            const unsigned tg = og / nx;
            if (og + 1u == (tg + 1u) * nx) xb_add(&bar[XB_TOPGEN], 1u);
            else XB_SPIN(xb_ld(&bar[XB_TOPGEN]) == tg, bar);
            __builtin_amdgcn_fence(__ATOMIC_ACQUIRE, "agent");
            xb_add(&bar[XB_XGEN(b.x)], 1u);
            asm volatile("s_waitcnt vmcnt(0)" ::: "memory");
        } else {
            XB_SPIN(xb_ld(&bar[XB_XGEN(b.x)]) == gen, bar);
            __builtin_amdgcn_fence(__ATOMIC_ACQUIRE, "agent");
            asm volatile("s_waitcnt vmcnt(0)" ::: "memory");
        }
    }
    __syncthreads();
}

#define XL_CNT(j)  (3584 + 64 * (j))
#define XL_GEN(j)  (4608 + 64 * (j))
__device__ __forceinline__ void xcd_local_barrier(const XcdBarrier& b, unsigned nloc) {
    asm volatile("s_waitcnt vmcnt(0)" ::: "memory");
    __syncthreads();
    if (threadIdx.x == 0) {
        unsigned* bar = b.bar;
        const unsigned n = b.st[5] + 1u; b.st[5] = n;
        const unsigned target = n * nloc;
        (void)xb_add(&bar[XL_CNT(b.x)], 1u);
        XB_SPIN(xb_ld(&bar[XL_CNT(b.x)]) < target, bar);
        __builtin_amdgcn_fence(__ATOMIC_ACQUIRE, "agent");
        asm volatile("s_waitcnt vmcnt(0)" ::: "memory");
    }
    __syncthreads();
}

#define XP_CNT(pm) (5632 + 64 * (pm))
__device__ __forceinline__ void panel_sync(const XcdBarrier& b, int pm) {
    asm volatile("s_waitcnt vmcnt(0)" ::: "memory");
    __syncthreads();
    if (threadIdx.x == 0) {
        unsigned* bar = b.bar;
        const unsigned n = b.st[6] + 1u; b.st[6] = n;
        (void)xb_add(&bar[XP_CNT(pm)], 1u);
        XB_SPIN(xb_ld(&bar[XP_CNT(pm)]) < 4u * n, bar);
        __builtin_amdgcn_fence(__ATOMIC_ACQUIRE, "agent");
        asm volatile("s_waitcnt vmcnt(0)" ::: "memory");
    }
    __syncthreads();
}

__global__ void __launch_bounds__(512, 2) trunk_fwd(Args a_) {
    extern __shared__ __attribute__((aligned(16))) unsigned char lds_raw[];
    LAS unsigned char* lds = (LAS unsigned char*)lds_raw;
    cg::grid_group grid = cg::this_grid();
    const int G = gridDim.x;
    const int wid0 = __builtin_amdgcn_readfirstlane(threadIdx.x >> 6);
    using namespace pg8;

    const int ph_lo = a_.ph_lo, ph_hi = a_.ph_hi;
    { volatile LAS unsigned* stw = (volatile LAS unsigned*)(lds + 131072); if (threadIdx.x < 8) stw[threadIdx.x] = 0u; }
    __syncthreads();
    XcdBarrier xbar = xcd_barrier_post((unsigned*)(a_.ws + WS_CTL), (volatile LAS unsigned*)(lds + 131072));
    for (int ph = ph_lo; ph < ph_hi; ++ph) {
        int bx = blockIdx.x, wid = wid0; asm volatile("" : "+s"(bx), "+s"(wid));
#define LANE_TID const int lane = fresh_lane(), tid = wid * 64 + lane; (void)tid
        volatile LAS unsigned* stw = (volatile LAS unsigned*)(lds + 131072);
        const bool xloc = (__builtin_amdgcn_readfirstlane((int)stw[3]) == 1);
        if (xloc) bx = __builtin_amdgcn_readfirstlane((int)(stw[2] * 8u + xbar.x));
        const int vcu = (G % 8 == 0) ? (bx % 8) * (G / 8) + bx / 8 : bx;
        const int gw = vcu * 8 + wid, NGW = G * 8;
        ArgP ap = (ArgP)__builtin_amdgcn_kernarg_segment_ptr(); asm volatile("" : "+s"(ap));
        unsigned char* ws = ap->ws;
        float* MOD = (float*)(ws + WS_MOD);
        bf16_t* H = (bf16_t*)(ws + WS_H); bf16_t* ZA = (bf16_t*)(ws + WS_ZA); bf16_t* ZG = (bf16_t*)(ws + WS_ZG); bf16_t* YS = (bf16_t*)(ws + WS_YS);
        bf16_t* CQN = (bf16_t*)(ws + WS_CQN); bf16_t* CKVN = (bf16_t*)(ws + WS_CKVN); bf16_t* KPE = (bf16_t*)(ws + WS_KPE); bf16_t* QM = (bf16_t*)(ws + WS_QM); bf16_t* KVM = (bf16_t*)(ws + WS_KVM);
        bf16_t* MGB = (bf16_t*)(ws + WS_MGB); bf16_t* HMID = (bf16_t*)(ws + WS_HMID);
        const float* COS = (const float*)(ws + WS_COS); const float* SIN = (const float*)(ws + WS_SIN);
        const float* xin0 = (const float*)ap->in[0];
        if (ph == 0) { LANE_TID; convert_weights(ap, 0, 1, lds, gw, NGW, wid, lane); __syncthreads(); phase_prologue(ap, vcu, G, gw, NGW, wid, lane, lds); }
        else if (ph == 1) continue;
        else if (ph == NPH - 1) {
            if (xloc && G == 256) continue;
            LANE_TID; const float* g = (const float*)ap->in[20];
            const int nb = xloc ? 2048 * (bx & 7) + (bx >> 3) * 8 + wid : gw, ns = xloc ? 256 : NGW, nl = xloc ? 2048 * ((bx & 7) + 1) : MT;
            for (int m = nb; m < nl; m += ns) norm_row<1>(ap->out + (size_t)m * 1024, g, nullptr, nullptr, nullptr, ap->out + (size_t)m * 1024, lane);
        } else {
            const int l = (ph - 2) / 10, k = (ph - 2) % 10;
            const bool fuse = xloc && (G == 256);
            if (fuse && (k == 7 || (k == 0 && l > 0))) continue;
            const float* modl = MOD + (size_t)l * 2 * 6144;
            const float* xcur = (l == 0) ? xin0 : ap->out;
            switch (k) {
            case 0: {
                LANE_TID;
                const int r0 = (8 * (bx & 7) + ((bx >> 3) & 7)) * 256 + (bx >> 6) * 64;
                const int nb = fuse ? r0 + wid : (xloc ? 2048 * (bx & 7) + (bx >> 3) * 8 + wid : gw), ns = fuse ? 8 : (xloc ? 256 : NGW), nl = fuse ? r0 + 64 : (xloc ? 2048 * ((bx & 7) + 1) : MT);
                phase_norm(xcur, (const float*)ap->in[5] + l * 1024, modl, 1024, 0, H, nb, ns, nl, lane);
            } break;
            case 1: {
                Gemm g{H, (const bf16_t*)(ws + WS_WIN), MT, NPAD, 1024, 1024, 1024}; StaticOrder S; S.init(MT, NPAD, G, bx);
                EpiInProj E{ZA, ZG};
                gemm_phase<EpiInProj, StaticOrder, false, true>(lds, g, S, E, fresh_tid(wid));
                { const int nfull = (MT / 256) * (NPAD / 256) % G; const int nb = (nfull == 0) ? G : G - nfull, b0 = (nfull == 0) ? 0 : nfull;
                  if (bx >= b0) { __syncthreads(); const int lane = fresh_lane(); convert_weights(ap, l, 2, lds, (bx - b0) * 8 + wid, nb * 8, wid, lane); } }
            } break;
            case 2: {
                LANE_TID;
                const float* sgn_g = (const float*)ap->in[8] + l * 512; const float* sg_b = (const float*)ap->in[10] + l * 512; const float* cw = (const float*)ap->in[11] + l * 1536;
                const float* gq = (const float*)ap->in[12] + l * 256; const float* gkv = (const float*)ap->in[14] + l * 128;
                { const int r0 = (8 * (bx & 7) + ((bx >> 3) & 7)) * 256 + (bx >> 6) * 64;
                  const int nb = fuse ? r0 + wid : (xloc ? 2048 * (bx & 7) + (bx >> 3) * 8 + wid : gw), ns = fuse ? 8 : (xloc ? 256 : NGW), nl = fuse ? r0 + 64 : (xloc ? 2048 * ((bx & 7) + 1) : MT);
                  for (int m = nb; m < nl; m += ns) mlaprep_row(m, ZA, gq, gkv, COS, SIN, CQN, CKVN, KPE, lane); }
                for (int u = vcu; u < 512 + 2048; u += G) {
                    if (u < 512) sg_unit(u >> 2, u & 3, ZA, (const bf16_t*)(ws + WS_SGW), sgn_g, sg_b, YS, lds, tid);
                    else conv_item(u - 512, ZA, cw, YS + (size_t)MT * 512, tid);
                }
                if (l + 1 < NL) { __syncthreads(); convert_weights(ap, l + 1, 1, lds, gw, NGW, wid, lane); }
            } break;
            case 3: {
                { Gemm g{CQN, (const bf16_t*)(ws + WS_WUQ), MT, 768, 256, 256, 256}; StaticOrder S; S.init(MT, 768, G, bx);
                  EpiMlaQ E{QM, COS, SIN, 0.10206207261596575f * LOG2E};
                  gemm_phase<EpiMlaQ, StaticOrder, true, true>(lds, g, S, E, fresh_tid(wid)); }
                { Gemm g{CKVN, (const bf16_t*)(ws + WS_WUKV), MT, 1024, 128, 128, 128}; StaticOrder S; S.init(MT, 1024, G, bx);
                  EpiBf16<0> E{KVM, 1024};
                  gemm_phase<EpiBf16<0>, StaticOrder, true, true>(lds, g, S, E, fresh_tid(wid)); }
            } break;
            case 4: {
                LANE_TID;
                for (int p = vcu; p < 256; p += G) {
                    const int bh = p >> 4, s = p & 15, b = bh >> 3, h = bh & 7;
                    mla_unit(b, h, 31 - s, QM, KVM, KPE, YS + (size_t)2 * MT * 512, lds, tid);
                    mla_unit(b, h, s, QM, KVM, KPE, YS + (size_t)2 * MT * 512, lds, tid);
                    sb_unit(b, h, 31 - s, ZA, YS + (size_t)3 * MT * 512, lds, tid);
                    sb_unit(b, h, s, ZA, YS + (size_t)3 * MT * 512, lds, tid);
                }
            } break;
            case 5: {
                Gemm g{YS, (const bf16_t*)(ws + WS_WBR), 4 * MT, 4 * 1024, 512, 512, 512}; BranchOrder S; S.so.init(MT, 1024, G, bx);
                EpiBranch E{ZG, MGB};
                gemm_phase<EpiBranch, BranchOrder, false, true>(lds, g, S, E, fresh_tid(wid));
            } break;
            case 8: {
                Gemm g{H, (const bf16_t*)(ws + WS_W1), MT, DFF, 1024, 1024, 1024}; StaticOrder S; S.init(MT, DFF, G, bx);
                EpiBf16<4> E{HMID, DFF};
                gemm_phase<EpiBf16<4>, StaticOrder, true, true>(lds, g, S, E, fresh_tid(wid));
            } break;
            case 7: {
                LANE_TID;
                const int nb = xloc ? 2048 * (bx & 7) + (bx >> 3) * 8 + wid : gw, ns = xloc ? 256 : NGW, nl = xloc ? 2048 * ((bx & 7) + 1) : MT;
                phase_norm(ap->out, (const float*)ap->in[6] + l * 1024, modl, 4096, 3072, H, nb, ns, nl, lane);
            } break;
            default: {
                const bool mix = (k == 6); const int K = mix ? 1024 : DFF;
                Gemm g{mix ? MGB : HMID, (const bf16_t*)(ws + (mix ? WS_WOUT : WS_W2)), MT, 1024, K, K, K}; StaticOrder S; S.init(MT, 1024, G, bx);
                EpiResid E{mix ? xcur : ap->out, ap->out, modl + (mix ? 2048 : 5120)};
                gemm_phase<EpiResid, StaticOrder, true, true>(lds, g, S, E, fresh_tid(wid));
                if (fuse) {
                    Unit u0; (void)S.next(0, u0);
                    panel_sync(xbar, u0.pm);
                    const int lane = fresh_lane(); const int r0 = u0.pm * 256 + u0.pn * 64;
                    if (mix) phase_norm(ap->out, (const float*)ap->in[6] + l * 1024, modl, 4096, 3072, H, r0 + wid, 8, r0 + 64, lane);
                    else if (l + 1 < NL) phase_norm(ap->out, (const float*)ap->in[5] + (l + 1) * 1024, MOD + (size_t)(l + 1) * 2 * 6144, 1024, 0, H, r0 + wid, 8, r0 + 64, lane);
                    else { const float* gf = (const float*)ap->in[20]; for (int m = r0 + wid; m < r0 + 64; m += 8) norm_row<1>(ap->out + (size_t)m * 1024, gf, nullptr, nullptr, nullptr, ap->out + (size_t)m * 1024, lane); }
                }
            } break;
            }
        }
        if (ph + 1 < ph_hi) {
            if (ph == ph_lo) {
                grid.sync();
                if (threadIdx.x == 0) { unsigned ok = (G % 8 == 0) ? 1u : 0u, npop = 0u;
                    for (unsigned j = 0; j < 16; ++j) { const unsigned c = xb_ld(&xbar.bar[XB_XCNT(j)]); if (c) { ++npop; if (c != (unsigned)G / 8u) ok = 0u; } }
                    stw[3] = (ok && npop == 8u) ? 1u : 2u; }
                __syncthreads();
            } else {
                const int kk = (ph >= 2 && ph < NPH - 1) ? (ph - 2) % 10 : -1;
                const bool fuse_s = xloc && (G == 256);
                const int my_pm = 8 * (bx & 7) + ((bx >> 3) & 7);
                if (fuse_s && kk == 9 && ph + 2 >= NPH - 1) { }
                else if (fuse_s && (kk == 0 || kk == 2 || kk == 5 || kk == 6 || kk == 8 || kk == 9)) panel_sync(xbar, my_pm);
                else if (xloc && (kk == 0 || kk == 2 || kk >= 5)) xcd_local_barrier(xbar, (unsigned)G / 8u); else xcd_barrier(xbar);
            }
        }
    }
}

#ifndef N_LAUNCH_MODE
#define N_LAUNCH_MODE 1
#endif
extern "C" void kernel_launch(void* const* d_in, const int* in_sizes, int n_in, void* d_out, int out_size, void* d_ws, size_t ws_size, hipStream_t stream) {
    static int grid = 0;
    if (grid == 0) {
        if (n_in != 21 || out_size != MT * 1024 || ws_size < WS_END) { fprintf(stderr, "kernel_launch: unexpected shapes (n_in %d, out %d, ws %zu): nothing launched\n", n_in, out_size, ws_size); grid = -1; return; }
        int dev = 0, cus = 0, per_cu = 0;
        if (hipGetDevice(&dev) != hipSuccess || hipDeviceGetAttribute(&cus, hipDeviceAttributeMultiprocessorCount, dev) != hipSuccess) { fprintf(stderr, "kernel_launch: device query failed\n"); grid = -1; return; }
        if (hipFuncSetAttribute((const void*)trunk_fwd, hipFuncAttributeMaxDynamicSharedMemorySize, LDS_BYTES) != hipSuccess) { fprintf(stderr, "kernel_launch: hipFuncSetAttribute failed\n"); grid = -1; return; }
        if (hipOccupancyMaxActiveBlocksPerMultiprocessor(&per_cu, (const void*)trunk_fwd, 512, LDS_BYTES) != hipSuccess || per_cu < 1) { fprintf(stderr, "kernel_launch: occupancy query says %d blocks per CU\n", per_cu); per_cu = 1; }
        (void)hipGetLastError();
        grid = cus * per_cu;
    }
    if (grid < 0) return;
    Args a{};
    for (int i = 0; i < 21; ++i) a.in[i] = d_in[i];
    a.out = (float*)d_out; a.ws = (unsigned char*)d_ws;
    void* args[] = {&a};
    if (hipMemsetAsync((char*)d_ws + WS_CTL, 0, 40960, stream) != hipSuccess) { fprintf(stderr, "kernel_launch: hipMemsetAsync of the barrier words failed\n"); return; }
#if DBG
    dbg_run(a, args, grid, stream);
#elif N_LAUNCH_MODE == 1
    a.ph_lo = 0; a.ph_hi = NPH;
    hipError_t e = hipLaunchCooperativeKernel((const void*)trunk_fwd, dim3(grid), dim3(512), args, LDS_BYTES, stream);
    if (e != hipSuccess) fprintf(stderr, "cooperative launch failed: %s (grid %d)\n", hipGetErrorString(e), grid);
#else
    for (int ph = 0; ph < NPH; ++ph) { a.ph_lo = ph; a.ph_hi = ph + 1;
        hipError_t e = hipLaunchCooperativeKernel((const void*)trunk_fwd, dim3(grid), dim3(512), args, LDS_BYTES, stream);
        if (e != hipSuccess) { fprintf(stderr, "launch of phase %d failed: %s (grid %d)\n", ph, hipGetErrorString(e), grid); break; } }
#endif
}
```

```cpp
#include <hip/hip_runtime.h>
#include <hip/hip_cooperative_groups.h>
#include <cstdio>
#include <cstdint>
namespace cg = cooperative_groups;

#ifndef DBG
#define DBG 0
#endif

#define LAS __attribute__((address_space(3)))
typedef unsigned short bf16_t;
typedef short bf16x8 __attribute__((ext_vector_type(8)));
typedef short s16x4 __attribute__((ext_vector_type(4)));
typedef float f32x2 __attribute__((ext_vector_type(2)));
typedef float f32x4 __attribute__((ext_vector_type(4)));
typedef float f32x16 __attribute__((ext_vector_type(16)));
typedef unsigned u32x2 __attribute__((ext_vector_type(2)));
typedef unsigned u32x4 __attribute__((ext_vector_type(4)));
typedef __bf16 bf16x2_t __attribute__((ext_vector_type(2)));

constexpr int MT = 16384, SEQ = 8192, DM = 1024, NL = 4, DFF = 4096;
constexpr int IN_COLS = 8608, NPAD = 8704, ZA_LD = 4608, ZG_LD = 4096;
constexpr int ZA_SGU = 0, ZA_SGV = 512, ZA_CB = 1024, ZA_CC = 1536, ZA_CX = 2048, ZA_CQ = 2560, ZA_CKV = 2816, ZA_KPE = 2944, ZA_SBQ = 3072, ZA_SBK = 3584, ZA_SBV = 4096;
constexpr float NORM_EPS = 1e-6f;
constexpr float LOG2E = 1.4426950408889634f, LN2 = 0.6931471805599453f;
constexpr size_t MiB = 1u << 20;
constexpr size_t WS_CTL = 0, CTL_BYTES = 1 * MiB;
constexpr size_t WS_MOD = 65536;
constexpr size_t WS_COS = 1 * MiB, WS_SIN = 2 * MiB;
constexpr size_t WS_SGW = 3 * MiB;
constexpr size_t WS_WIN = 4 * MiB;
constexpr size_t WS_WUQ = 21 * MiB, WS_WUKV = 22 * MiB, WS_WBR = 23 * MiB, WS_WOUT = 27 * MiB, WS_W1 = 29 * MiB, WS_W2 = 37 * MiB;
constexpr size_t WS_H = 46 * MiB;
constexpr size_t WS_ZA = 78 * MiB;
constexpr size_t WS_ZG = 222 * MiB;
constexpr size_t WS_YS = 350 * MiB;
constexpr size_t WS_CQN = 414 * MiB, WS_CKVN = 422 * MiB, WS_KPE = 426 * MiB, WS_QM = 427 * MiB, WS_KVM = 451 * MiB, WS_END = 483 * MiB;
constexpr size_t WS_MGF = WS_ZA, WS_MGB = WS_ZA + 64 * MiB;
constexpr size_t WS_HMID = WS_ZG;

constexpr int LDS_BYTES = 135168;

__device__ __forceinline__ float bf2f(unsigned v) { return __uint_as_float(v << 16); }
__device__ __forceinline__ unsigned pk2(float lo, float hi) { f32x2 v = {lo, hi}; bf16x2_t b = __builtin_convertvector(v, bf16x2_t); return __builtin_bit_cast(unsigned, b); }
__device__ __forceinline__ bf16_t f2bf(float f) { return (bf16_t)(pk2(f, 0.f) & 0xffffu); }
__device__ __forceinline__ float shx(float v, int mask, int lane) { return __int_as_float(__builtin_amdgcn_ds_bpermute((lane ^ mask) << 2, __float_as_int(v))); }
__device__ __forceinline__ float shl(float v, int src) { return __int_as_float(__builtin_amdgcn_ds_bpermute(src << 2, __float_as_int(v))); }
__device__ __forceinline__ float rdl(float v, int src_uniform) { return __int_as_float(__builtin_amdgcn_readlane(__float_as_int(v), src_uniform)); }
__device__ __forceinline__ float wave_sum(float v, int lane) {
#pragma unroll
    for (int o = 1; o < 64; o <<= 1) v += shx(v, o, lane);
    return v;
}
__device__ __forceinline__ int crow(int r, int hi) { return (r & 3) + 8 * (r >> 2) + 4 * hi; }
__device__ __forceinline__ float fexp2(float x) { return __builtin_amdgcn_exp2f(x); }
__device__ __forceinline__ float flog2(float x) { return __builtin_amdgcn_logf(x); }
__device__ __forceinline__ float frcp(float x) { return __builtin_amdgcn_rcpf(x); }
__device__ __forceinline__ float gelu_tanh(float x) { const float u = 0.7978845608028654f * (x + 0.044715f * x * x * x); return x * frcp(1.f + fexp2(-2.f * LOG2E * u)); }
__device__ __forceinline__ float sigmoidf_(float x) { return frcp(1.f + fexp2(-LOG2E * x)); }
__device__ __forceinline__ void unpack8(u32x4 w, float* f) {
    f[0] = bf2f(w.x & 0xffffu); f[1] = bf2f(w.x >> 16); f[2] = bf2f(w.y & 0xffffu); f[3] = bf2f(w.y >> 16);
    f[4] = bf2f(w.z & 0xffffu); f[5] = bf2f(w.z >> 16); f[6] = bf2f(w.w & 0xffffu); f[7] = bf2f(w.w >> 16);
}
#define MFMA32(a, b, c) __builtin_amdgcn_mfma_f32_32x32x16_bf16((a), (b), (c), 0, 0, 0)
__device__ __forceinline__ int fresh_lane() { int l; asm volatile("v_mbcnt_lo_u32_b32 %0, -1, 0\n\tv_mbcnt_hi_u32_b32 %0, -1, %0" : "=v"(l)); return l; }
__device__ __forceinline__ int fresh_tid(int wid) { return wid * 64 + fresh_lane(); }
__device__ __forceinline__ float max3f(float a, float b, float c) { float r; asm("v_max3_f32 %0, %1, %2, %3" : "=v"(r) : "v"(a), "v"(b), "v"(c)); return r; }
__device__ __forceinline__ float max2f(float a, float b) { float r; asm("v_max_f32_e32 %0, %1, %2" : "=v"(r) : "v"(a), "v"(b)); return r; }
namespace pg8 {
#define PG8_LAS __attribute__((address_space(3)))


constexpr int BM = 256, BK = 64, HALF = 128, HTB = HALF * BK * 2  , STAGE_BYTES = 8 * HTB, NXCD = 8, WGM = 8;

__host__ __device__ __forceinline__ int lds_byte(int r, int c) { const int st = (r >> 4) * 2 + (c >> 5), rr = r & 15, cc = c & 31, ob = rr * 64 + cc * 2; return st * 1024 + (ob ^ (((ob >> 9) & 1) << 5)); }
__host__ __device__ __forceinline__ void stage_rc(int b, int& R, int& C) { const int st = b / 1024, sb = b % 1024, swz = sb ^ (((sb >> 9) & 1) << 5); R = (st >> 1) * 16 + swz / 64; C = (st & 1) * 32 + (swz % 64) / 2; }
__host__ __device__ __forceinline__ int perm32(int rho) { const int n = rho >> 4, i = rho & 15; return 8 * (i >> 2) + 4 * n + (i & 3); }

struct Unit { int pm, pn; };
struct Gemm { const bf16_t* A; const bf16_t* Bt; int M, N, K, lda, ldb; };

struct StaticOrder {
    int nM, nN, nwg, G, c;
    __host__ __device__ void init(int M, int N, int G_, int c_) { nM = M / BM; nN = N / BM; nwg = nM * nN; G = G_; c = c_; }
    __host__ __device__ bool next(int i, Unit& u) const {
        const int L = i * G + c; if (L >= nwg) return false;
        int wgid = (int)L; { const int q = nwg / NXCD, r = nwg % NXCD, xcd = wgid % NXCD, off = wgid / NXCD; wgid = (xcd < r ? xcd * (q + 1) : r * (q + 1) + (xcd - r) * q) + off; }
        const int nig = WGM * nN, gid = wgid / nig, fm = gid * WGM, gsz = (nM - fm) < WGM ? (nM - fm) : WGM;
        u.pm = fm + ((wgid % nig) % gsz); u.pn = (wgid % nig) / gsz; return true;
    }
    __device__ __forceinline__ void a_ready(const Unit&) const {}
    __device__ __forceinline__ void done(const Unit&) const {}
};

template <int MODE> __device__ __forceinline__ float actf(float v) {
    if (MODE == 1) return gelu_tanh(v);
    if (MODE == 2) return v * (0.125f * LOG2E);
    if (MODE == 3) return sigmoidf_(v);
    if (MODE == 4) { const float r = v > 0.f ? v : 0.f; return r * r; }
    return v;
}
template <int MODE> __device__ __forceinline__ void store_tile_perm(const f32x4 (&acc)[2][2][4][2], bf16_t* base, int ld, int pm, int colt, int wr, int wc, int fr, int fq) {
    const int row0 = pm * BM + wr * 64 + fr, col0 = colt + wc * 32 + 8 * fq;
#pragma unroll
    for (int ai = 0; ai < 2; ++ai)
#pragma unroll
        for (int m = 0; m < 4; ++m) { bf16_t* rowp = base + (size_t)(row0 + ai * HALF + m * 16) * ld + col0;
#pragma unroll
            for (int bj = 0; bj < 2; ++bj) { const f32x4 v0 = acc[ai][bj][m][0], v1 = acc[ai][bj][m][1];
                u32x4 w; w.x = pk2(actf<MODE>(v0[0]), actf<MODE>(v0[1])); w.y = pk2(actf<MODE>(v0[2]), actf<MODE>(v0[3]));
                w.z = pk2(actf<MODE>(v1[0]), actf<MODE>(v1[1])); w.w = pk2(actf<MODE>(v1[2]), actf<MODE>(v1[3]));
                *(u32x4*)(rowp + bj * HALF) = w; } }
}
template <int MODE> struct EpiBf16 {
    static constexpr bool PERM = true, AFTER_DRAIN = false, KEEP_ACC = false;
    bf16_t* O; int ldc;
    __device__ __forceinline__ void operator()(const f32x4 (&acc)[2][2][4][2], const Unit& u, int wr, int wc, int fr, int fq) const { store_tile_perm<MODE>(acc, O, ldc, u.pm, u.pn * BM, wr, wc, fr, fq); }
};
struct EpiInProj {
    static constexpr bool PERM = true, AFTER_DRAIN = false, KEEP_ACC = false;
    bf16_t* ZA; bf16_t* ZG;
    __device__ __forceinline__ void operator()(const f32x4 (&acc)[2][2][4][2], const Unit& u, int wr, int wc, int fr, int fq) const {
        const int pn = u.pn;
        if (pn < 4) store_tile_perm<1>(acc, ZA, ZA_LD, u.pm, pn * BM, wr, wc, fr, fq);
        else if (pn == 12 || pn == 13) store_tile_perm<2>(acc, ZA, ZA_LD, u.pm, pn * BM, wr, wc, fr, fq);
        else if (pn < 18) store_tile_perm<0>(acc, ZA, ZA_LD, u.pm, pn * BM, wr, wc, fr, fq);
        else store_tile_perm<3>(acc, ZG, ZG_LD, u.pm, (pn - 18) * BM, wr, wc, fr, fq);
    }
};
struct EpiMlaQ {
    static constexpr bool PERM = false, AFTER_DRAIN = false, KEEP_ACC = false;
    bf16_t* QM; const float* COS; const float* SIN; float qs;
    __device__ __forceinline__ void operator()(const f32x4 (&acc)[2][2][4][2], const Unit& u, int wr, int wc, int fr, int fq) const {
        const int row0 = u.pm * BM + wr * 64 + fr;
#pragma unroll
        for (int bj = 0; bj < 2; ++bj) {
            const int g32 = 8 * u.pn + 4 * bj + wc; const bool pe = (g32 % 3) == 2; const int colb = u.pn * BM + bj * HALF + wc * 32 + 4 * fq;
            f32x4 cv[2][4], sv[2][4];
            if (pe) {
#pragma unroll
                for (int ai = 0; ai < 2; ++ai)
#pragma unroll
                    for (int m = 0; m < 4; ++m) { const size_t ro = (size_t)(row0 + ai * HALF + m * 16) * 16 + 4 * fq; cv[ai][m] = *(const f32x4*)(COS + ro); sv[ai][m] = *(const f32x4*)(SIN + ro); }
                asm volatile("" ::: "memory");
            }
#pragma unroll
            for (int ai = 0; ai < 2; ++ai)
#pragma unroll
                for (int m = 0; m < 4; ++m) { const int row = row0 + ai * HALF + m * 16;
                    f32x4 x1 = acc[ai][bj][m][0] * qs, x2 = acc[ai][bj][m][1] * qs;
                    if (pe) { const f32x4 c = cv[ai][m], s = sv[ai][m];
                        const f32x4 o1 = x1 * c - x2 * s, o2 = x2 * c + x1 * s; x1 = o1; x2 = o2; }
                    u32x2 w1, w2; w1.x = pk2(x1[0], x1[1]); w1.y = pk2(x1[2], x1[3]); w2.x = pk2(x2[0], x2[1]); w2.y = pk2(x2[2], x2[3]);
                    bf16_t* p = QM + (size_t)row * 768 + colb; *(u32x2*)p = w1; *(u32x2*)(p + 16) = w2; }
        }
    }
};
struct EpiBranch {
    static constexpr bool PERM = true, AFTER_DRAIN = false, KEEP_ACC = true;
    const bf16_t* ZG; bf16_t* MGB;
    __device__ __forceinline__ void operator()(f32x4 (&acc)[2][2][4][2], const Unit& u, int wr, int wc, int fr, int fq) const {
        const int br = u.pm >> 6, pm = u.pm & 63, pn = u.pn & 3;
        const int row0 = pm * BM + wr * 64 + fr, col0 = pn * BM + wc * 32 + 8 * fq;
        const float GMIN = 1e-30f;
#pragma unroll
        for (int ai = 0; ai < 2; ++ai) {
            u32x4 gk[4][2], gn[4][2];
#pragma unroll
            for (int m = 0; m < 4; ++m)
#pragma unroll
                for (int bj = 0; bj < 2; ++bj) { const bf16_t* gp = ZG + (size_t)(row0 + ai * HALF + m * 16) * ZG_LD + br * 1024 + col0 + bj * HALF;
                    gk[m][bj] = *(const u32x4*)gp; if (br < 3) gn[m][bj] = *(const u32x4*)(gp + 1024); }
            asm volatile("" ::: "memory");
#pragma unroll
            for (int m = 0; m < 4; ++m)
#pragma unroll
                for (int bj = 0; bj < 2; ++bj) {
                    float g[8]; unpack8(gk[m][bj], g);
#pragma unroll
                    for (int e = 0; e < 8; ++e) g[e] = g[e] > GMIN ? g[e] : GMIN;
                    if (br < 3) { float n[8]; unpack8(gn[m][bj], n);
#pragma unroll
                        for (int e = 0; e < 8; ++e) g[e] *= frcp(n[e] > GMIN ? n[e] : GMIN); }
                    f32x4 v0 = acc[ai][bj][m][0], v1 = acc[ai][bj][m][1];
                    v0[0] *= g[0]; v0[1] *= g[1]; v0[2] *= g[2]; v0[3] *= g[3]; v1[0] *= g[4]; v1[1] *= g[5]; v1[2] *= g[6]; v1[3] *= g[7];
                    if (br < 3) { acc[ai][bj][m][0] = v0; acc[ai][bj][m][1] = v1; }
                    else { u32x4 w; w.x = pk2(v0[0], v0[1]); w.y = pk2(v0[2], v0[3]); w.z = pk2(v1[0], v1[1]); w.w = pk2(v1[2], v1[3]);
                        *(u32x4*)(MGB + (size_t)(row0 + ai * HALF + m * 16) * 1024 + col0 + bj * HALF) = w;
                        acc[ai][bj][m][0] = (f32x4){0.f, 0.f, 0.f, 0.f}; acc[ai][bj][m][1] = (f32x4){0.f, 0.f, 0.f, 0.f}; }
                }
        }
    }
};
struct EpiResid {
    static constexpr bool PERM = false, AFTER_DRAIN = false, KEEP_ACC = false;
    const float* xin; float* xout; const float* gate;
    __device__ __forceinline__ void operator()(const f32x4 (&acc)[2][2][4][2], const Unit& u, int wr, int wc, int fr, int fq) const {
        const int row0 = u.pm * BM + wr * 64 + fr, col0 = u.pn * BM + wc * 32 + 4 * fq;
        const float* g = gate + (size_t)(u.pm >> 5) * 6144;
#pragma unroll
        for (int bj = 0; bj < 2; ++bj)
#pragma unroll
            for (int n = 0; n < 2; ++n) { const int col = col0 + bj * HALF + n * 16; const f32x4 gv = *(const f32x4*)(g + col);
                f32x4 xiv[2][4];
#pragma unroll
                for (int ai = 0; ai < 2; ++ai)
#pragma unroll
                    for (int m = 0; m < 4; ++m) xiv[ai][m] = *(const f32x4*)(xin + (size_t)(row0 + ai * HALF + m * 16) * 1024 + col);
                asm volatile("" ::: "memory");
#pragma unroll
                for (int ai = 0; ai < 2; ++ai)
#pragma unroll
                    for (int m = 0; m < 4; ++m) { const size_t off = (size_t)(row0 + ai * HALF + m * 16) * 1024 + col; *(f32x4*)(xout + off) = xiv[ai][m] + gv * acc[ai][bj][m][n]; } }
    }
};
struct BranchOrder {
    StaticOrder so;
    __device__ bool next(int i, Unit& u) const { Unit t; if (!so.next(i >> 2, t)) return false; const int br = i & 3; u.pm = br * 64 + t.pm; u.pn = br * 4 + t.pn; return true; }
    __device__ __forceinline__ void a_ready(const Unit&) const {}
    __device__ __forceinline__ void done(const Unit&) const {}
};

template <class Epi, class Sched, bool ALIGN_EPI = false, bool SP2 = false>
__device__ __forceinline__ void gemm_phase(PG8_LAS unsigned char* lds, const Gemm g, const Sched& S, const Epi& E, int tid_in) {
    int tid = tid_in; asm volatile("" : "+v"(tid)); float zf = 0.f; asm volatile("" : "+v"(zf));
    const int wid = __builtin_amdgcn_readfirstlane(tid >> 6), lane = tid & 63, wr = wid >> 2, wc = wid & 3, fr = lane & 15, fq = lane >> 4;
    const int K = g.K, nt = K / BK;
    unsigned voffA[2], voffB[2];
#pragma unroll
    for (int i = 0; i < 2; ++i) { int R, C; stage_rc(tid * 16 + i * 8192, R, C); const int Rb = Epi::PERM ? ((R & ~31) + perm32(R & 31)) : R;
        voffA[i] = (unsigned)(R * g.lda + C) * 2u; voffB[i] = (unsigned)(Rb * g.ldb + C) * 2u; }
    const unsigned voffA0 = voffA[0], voffB0 = voffB[0]; const unsigned p1A = 64u * (unsigned)g.lda * 2u, p1B = 64u * (unsigned)g.ldb * 2u;
    const size_t kstep = (size_t)(BK * 2);
    const size_t hstepA = (size_t)HALF * g.lda * 2, hstepB = (size_t)HALF * g.ldb * 2;
    const size_t tstepA = 2 * hstepA, tstepB = 2 * hstepB;
    const unsigned ldsw = (unsigned)wid * 1024u;
    const int aoff = lds_byte(wr * 64 + fr, fq * 8), boff = lds_byte(wc * 32 + fr, fq * 8);
#define PG8_SA(b, h) (((b) * 2 + (h)) * HTB)
#define PG8_SB(b, h) ((4 + (b) * 2 + (h)) * HTB)
#define PG8_STAGE(bufoff, gbase, voff, p1) do { _Pragma("unroll") for (int _i = 0; _i < 2; ++_i) { \
        const char* gb_ = (const char*)(gbase) + (size_t)_i * (p1); asm volatile("" : "+s"(gb_));     \
        __builtin_amdgcn_global_load_lds((const unsigned*)(gb_ + (voff)), (PG8_LAS unsigned*)(lds + (bufoff) + ldsw + _i * 8192), 16, 0, 0); } } while (0)
#define PG8_LDA(dst, b, h) do { _Pragma("unroll") for (int m = 0; m < 4; ++m) _Pragma("unroll") for (int k = 0; k < 2; ++k) dst[m][k] = *(const PG8_LAS bf16x8*)(lds + PG8_SA(b, h) + aoff + m * 2048 + k * 1024); } while (0)
#define PG8_LDB(dst, b, h) do { _Pragma("unroll") for (int n = 0; n < 2; ++n) _Pragma("unroll") for (int k = 0; k < 2; ++k) dst[n][k] = *(const PG8_LAS bf16x8*)(lds + PG8_SB(b, h) + boff + n * 2048 + k * 1024); } while (0)
#define PG8_MMA(ai, bj, At, Bt) do { __builtin_amdgcn_s_setprio(1); _Pragma("unroll") for (int m = 0; m < 4; ++m) _Pragma("unroll") for (int n = 0; n < 2; ++n) _Pragma("unroll") for (int k = 0; k < 2; ++k) \
        acc[ai][bj][m][n] = __builtin_amdgcn_mfma_f32_16x16x32_bf16(Bt[n][k], At[m][k], acc[ai][bj][m][n], 0, 0, 0); __builtin_amdgcn_s_setprio(0); } while (0)
#define PG8_WAIT_V(n) asm volatile("s_waitcnt vmcnt(" #n ")" ::: "memory")
#define PG8_WAIT_L(n) asm volatile("s_waitcnt lgkmcnt(" #n ")" ::: "memory")
#define PG8_BAR __builtin_amdgcn_s_barrier()
#define PG8_SCHED __builtin_amdgcn_sched_barrier(0)
    Unit cur, nxt; int ui = 0;
    if (!S.next(0, cur)) return;
    f32x4 acc[2][2][4][2];
#pragma unroll
    for (int a = 0; a < 2; ++a)
#pragma unroll
        for (int b = 0; b < 2; ++b)
#pragma unroll
            for (int m = 0; m < 4; ++m)
#pragma unroll
                for (int n = 0; n < 2; ++n) acc[a][b][m][n] = (f32x4){zf, zf, zf, zf};
    bf16x8 At[4][2], B0[2][2], B1[2][2];
    const char* cA = (const char*)g.A + (size_t)cur.pm * tstepA; const char* cB = (const char*)g.Bt + (size_t)cur.pn * tstepB;
    S.a_ready(cur);
    if constexpr (SP2) {
        PG8_STAGE(PG8_SB(0, 0), cB, voffB0, p1B); PG8_STAGE(PG8_SB(0, 1), cB + hstepB, voffB0, p1B); PG8_STAGE(PG8_SA(0, 0), cA, voffA0, p1A); PG8_STAGE(PG8_SA(0, 1), cA + hstepA, voffA0, p1A);
        if (wr == 1) PG8_BAR;
        PG8_WAIT_V(2); PG8_BAR;
        PG8_STAGE(PG8_SB(1, 0), cB + kstep, voffB0, p1B); PG8_STAGE(PG8_SA(1, 0), cA + kstep, voffA0, p1A); PG8_STAGE(PG8_SB(1, 1), cB + hstepB + kstep, voffB0, p1B);
        PG8_WAIT_V(6); PG8_BAR;
    } else {
        PG8_STAGE(PG8_SB(0, 0), cB, voffB0, p1B); PG8_STAGE(PG8_SA(0, 0), cA, voffA0, p1A); PG8_STAGE(PG8_SB(0, 1), cB + hstepB, voffB0, p1B); PG8_STAGE(PG8_SA(0, 1), cA + hstepA, voffA0, p1A);
        if (wr == 1) PG8_BAR;
        PG8_WAIT_V(4); PG8_BAR;
        PG8_STAGE(PG8_SB(1, 0), cB + kstep, voffB0, p1B); PG8_STAGE(PG8_SA(1, 0), cA + kstep, voffA0, p1A); PG8_STAGE(PG8_SB(1, 1), cB + hstepB + kstep, voffB0, p1B);
        PG8_WAIT_V(6); PG8_BAR;
    }
    for (;;) {
        const bool has_next = S.next(ui + 1, nxt);
        const char* nA = has_next ? (const char*)g.A + (size_t)nxt.pm * tstepA : cA; const char* nB = has_next ? (const char*)g.Bt + (size_t)nxt.pn * tstepB : cB;
        for (int t = 0; t < nt; t += 2) {
            const bool last = (t == nt - 2);
            const char* a1 = cA + (size_t)(t + 1) * kstep;
            const char* a2 = last ? nA : cA + (size_t)(t + 2) * kstep; const char* b2 = last ? nB : cB + (size_t)(t + 2) * kstep;
            const char* a3 = a2 + kstep; const char* b3 = b2 + kstep;
            if (last && has_next) S.a_ready(nxt);
            if constexpr (SP2) {
            PG8_LDB(B0, 0, 0); PG8_LDB(B1, 0, 1); PG8_SCHED; PG8_LDA(At, 0, 0); PG8_STAGE(PG8_SA(1, 1), a1 + hstepA, voffA0, p1A);
            PG8_WAIT_V(8); PG8_WAIT_L(0); PG8_BAR; PG8_MMA(0, 0, At, B0); PG8_MMA(0, 1, At, B1); PG8_BAR; PG8_SCHED;
            PG8_LDA(At, 0, 1); PG8_STAGE(PG8_SB(0, 0), b2, voffB0, p1B); PG8_STAGE(PG8_SB(0, 1), b2 + hstepB, voffB0, p1B); PG8_STAGE(PG8_SA(0, 0), a2, voffA0, p1A);
            PG8_WAIT_V(8); PG8_WAIT_L(0); PG8_BAR; PG8_MMA(1, 0, At, B0); PG8_MMA(1, 1, At, B1); PG8_BAR; PG8_SCHED;
            PG8_LDB(B0, 1, 0); PG8_LDB(B1, 1, 1); PG8_SCHED; PG8_LDA(At, 1, 0); PG8_STAGE(PG8_SA(0, 1), a2 + hstepA, voffA0, p1A);
            PG8_WAIT_V(8); PG8_WAIT_L(0); PG8_BAR; PG8_MMA(0, 0, At, B0); PG8_MMA(0, 1, At, B1); PG8_BAR; PG8_SCHED;
            PG8_LDA(At, 1, 1); PG8_STAGE(PG8_SB(1, 0), b3, voffB0, p1B); PG8_STAGE(PG8_SB(1, 1), b3 + hstepB, voffB0, p1B); PG8_STAGE(PG8_SA(1, 0), a3, voffA0, p1A);
            PG8_WAIT_V(8); PG8_WAIT_L(0); PG8_BAR; PG8_MMA(1, 0, At, B0); PG8_MMA(1, 1, At, B1); PG8_BAR; PG8_SCHED;
            } else {
            PG8_LDB(B0, 0, 0); PG8_SCHED; PG8_LDA(At, 0, 0); PG8_STAGE(PG8_SA(1, 1), a1 + hstepA, voffA0, p1A);
            PG8_WAIT_L(8); PG8_BAR; PG8_WAIT_L(0); PG8_MMA(0, 0, At, B0); PG8_BAR; PG8_SCHED;
            PG8_LDB(B1, 0, 1); PG8_STAGE(PG8_SB(0, 0), b2, voffB0, p1B);
            PG8_BAR; PG8_WAIT_L(0); PG8_MMA(0, 1, At, B1); PG8_BAR;
            PG8_LDA(At, 0, 1); PG8_STAGE(PG8_SA(0, 0), a2, voffA0, p1A);
            PG8_BAR; PG8_WAIT_L(0); PG8_MMA(1, 0, At, B0); PG8_BAR; PG8_SCHED;
            PG8_STAGE(PG8_SB(0, 1), b2 + hstepB, voffB0, p1B);
            PG8_WAIT_V(6); PG8_BAR; PG8_MMA(1, 1, At, B1); PG8_BAR;
            PG8_LDB(B0, 1, 0); PG8_SCHED; PG8_LDA(At, 1, 0); PG8_STAGE(PG8_SA(0, 1), a2 + hstepA, voffA0, p1A);
            PG8_WAIT_L(8); PG8_BAR; PG8_WAIT_L(0); PG8_MMA(0, 0, At, B0); PG8_BAR; PG8_SCHED;
            PG8_LDB(B1, 1, 1); PG8_STAGE(PG8_SB(1, 0), b3, voffB0, p1B);
            PG8_BAR; PG8_WAIT_L(0); PG8_MMA(0, 1, At, B1); PG8_BAR;
            PG8_LDA(At, 1, 1); PG8_STAGE(PG8_SA(1, 0), a3, voffA0, p1A);
            PG8_BAR; PG8_WAIT_L(0); PG8_MMA(1, 0, At, B0); PG8_BAR; PG8_SCHED;
            PG8_STAGE(PG8_SB(1, 1), b3 + hstepB, voffB0, p1B);
            PG8_WAIT_V(6); PG8_BAR; PG8_MMA(1, 1, At, B1); PG8_BAR;
            }
        }
        if constexpr (ALIGN_EPI) { if (wr == 0) PG8_BAR; }
        if constexpr (!Epi::AFTER_DRAIN) { int ln_; asm volatile("v_mbcnt_lo_u32_b32 %0, -1, 0\n\tv_mbcnt_hi_u32_b32 %0, -1, %0" : "=v"(ln_)); const int fr_ = ln_ & 15, fq_ = ln_ >> 4;
            E(acc, cur, wr, wc, fr_, fq_); S.done(cur); }
        if (!has_next) break;
        if constexpr (!Epi::KEEP_ACC) {
#pragma unroll
        for (int a = 0; a < 2; ++a)
#pragma unroll
            for (int b = 0; b < 2; ++b)
#pragma unroll
                for (int m = 0; m < 4; ++m)
#pragma unroll
                    for (int n = 0; n < 2; ++n) acc[a][b][m][n] = (f32x4){zf, zf, zf, zf};
        }
        cur = nxt; cA = nA; cB = nB; ++ui;
        if constexpr (ALIGN_EPI) { if (wr == 1) PG8_BAR; }
    }
    PG8_WAIT_V(0);
    if constexpr (!ALIGN_EPI) { if (wr == 0) PG8_BAR; }
    PG8_BAR;
    if constexpr (Epi::AFTER_DRAIN) { E.fused(acc, cur, wr, wc, fr, fq, lds, wid, lane); S.done(cur); }
#undef PG8_SA
#undef PG8_SB
#undef PG8_STAGE
#undef PG8_LDA
#undef PG8_LDB
#undef PG8_MMA
#undef PG8_WAIT_V
#undef PG8_WAIT_L
#undef PG8_BAR
#undef PG8_SCHED
}
}

struct Args { const void* in[21]; float* out; unsigned char* ws; int ph_lo, ph_hi; };
typedef const __attribute__((address_space(4))) Args* ArgP;
constexpr int NPH = 43;
__constant__ float INV_FREQ[16] = {1.0f, 0.5623413251903491f, 0.31622776601683794f, 0.1778279410038923f, 0.1f, 0.05623413251903491f, 0.03162277660168379f, 0.01778279410038923f,
                                   0.01f, 0.005623413251903491f, 0.0031622776601683794f, 0.0017782794100389228f, 0.001f, 0.0005623413251903491f, 0.00031622776601683794f, 0.00017782794100389227f};

__device__ __forceinline__ void phase_prologue(ArgP ap, int vcu, int G, int gw, int NGW, int wid, int lane, LAS unsigned char* lds) {
    const float* cvec = (const float*)ap->in[1]; const int* pos = (const int*)ap->in[2]; const float* ada_w = (const float*)ap->in[3]; const float* ada_b = (const float*)ap->in[4];
    float* MOD = (float*)(ap->ws + WS_MOD);
    LAS float* red = (LAS float*)(lds + 73728);
    for (int it = vcu; it < 4 * 96; it += G) {
        const int l = it / 96, cb = it % 96, ks = wid, col = cb * 64 + lane;
        const float* w = ada_w + ((size_t)l * 1024 + ks * 128) * 6144 + col;
        float c00 = cvec[ks * 128 + lane], c01 = cvec[ks * 128 + 64 + lane], c10 = cvec[1024 + ks * 128 + lane], c11 = cvec[1024 + ks * 128 + 64 + lane];
        c00 = c00 / (1.f + __expf(-c00)); c01 = c01 / (1.f + __expf(-c01)); c10 = c10 / (1.f + __expf(-c10)); c11 = c11 / (1.f + __expf(-c11));
        float a0 = 0.f, a1 = 0.f;
#pragma unroll 16
        for (int k = 0; k < 64; ++k) { const float wv = w[(size_t)k * 6144]; a0 += wv * rdl(c00, k); a1 += wv * rdl(c10, k); }
#pragma unroll 16
        for (int k = 0; k < 64; ++k) { const float wv = w[(size_t)(64 + k) * 6144]; a0 += wv * rdl(c01, k); a1 += wv * rdl(c11, k); }
        red[(wid * 2 + 0) * 64 + lane] = a0; red[(wid * 2 + 1) * 64 + lane] = a1;
        __syncthreads();
        if (wid < 2) { float s = ada_b[l * 6144 + col];
#pragma unroll
            for (int k8 = 0; k8 < 8; ++k8) s += red[(k8 * 2 + wid) * 64 + lane];
            MOD[((size_t)l * 2 + wid) * 6144 + col] = s; }
        __syncthreads();
    }
    float* COS = (float*)(ap->ws + WS_COS); float* SIN = (float*)(ap->ws + WS_SIN);
    for (int idx = gw * 64 + lane; idx < MT * 16; idx += NGW * 64) {
        const int row = idx >> 4, i = idx & 15;
        const float ang = (float)pos[row] * INV_FREQ[i];
        const double t = (double)ang * 0.6366197723675814; const double kq = rint(t); const double rr = (double)ang - kq * 1.5707963267948966;
        const int q = ((int)kq) & 3; const float rf = (float)rr, r2 = rf * rf;
        const float s = rf * (1.f + r2 * (-1.6666666667e-1f + r2 * (8.3333333333e-3f + r2 * (-1.9841269841e-4f + r2 * 2.7557319224e-6f))));
        const float c = 1.f + r2 * (-0.5f + r2 * (4.1666666667e-2f + r2 * (-1.3888888889e-3f + r2 * (2.4801587302e-5f + r2 * -2.7557319224e-7f))));
        COS[idx] = (q == 0) ? c : (q == 1) ? -s : (q == 2) ? -c : s;
        SIN[idx] = (q == 0) ? s : (q == 1) ? c : (q == 2) ? -s : -c;
    }
}
__device__ __forceinline__ void phase_modreduce(ArgP ap, int gw, int NGW, int lane) {
    const float* MODP = (const float*)(ap->ws + WS_H); float* MOD = (float*)(ap->ws + WS_MOD); const float* ada_b = (const float*)ap->in[4];
    for (int idx = gw * 64 + lane; idx < 4 * 2 * 6144; idx += NGW * 64) {
        const int l = idx / 12288, col = idx % 6144; float s = ada_b[l * 6144 + col];
#pragma unroll
        for (int ks = 0; ks < 8; ++ks) s += MODP[(size_t)ks * 49152 + idx];
        MOD[idx] = s;
    }
}

__device__ __forceinline__ void transpose_item(const float* W, int K, int N, bf16_t* WT, int split_at, int split_add, LAS float* scr, int item, int lane) {
    const int nblk = N / 32, kb = item / nblk, nb = item % nblk, k0 = 64 * kb, n0 = 32 * nb; const int row_off = (n0 >= split_at) ? split_add : 0;
    { f32x4 v[8]; const int c4 = (lane & 7) * 4;
#pragma unroll
      for (int i = 0; i < 8; ++i) v[i] = *(const f32x4*)(W + (size_t)(k0 + 8 * i + (lane >> 3)) * N + n0 + c4);
#pragma unroll
      for (int i = 0; i < 8; ++i) { LAS float* d = scr + (8 * i + (lane >> 3)) * 33 + c4; d[0] = v[i][0]; d[1] = v[i][1]; d[2] = v[i][2]; d[3] = v[i][3]; } }
    asm volatile("s_waitcnt lgkmcnt(0)" ::: "memory");
    const int c = lane & 7;
#pragma unroll
    for (int j = 0; j < 4; ++j) { const int n = (lane >> 3) + 8 * j; const LAS float* s = scr + (8 * c) * 33 + n;
        u32x4 o; o.x = pk2(s[0 * 33], s[1 * 33]); o.y = pk2(s[2 * 33], s[3 * 33]); o.z = pk2(s[4 * 33], s[5 * 33]); o.w = pk2(s[6 * 33], s[7 * 33]);
        *(u32x4*)(WT + (size_t)(row_off + n0 + n) * K + k0 + 8 * c) = o; }
    asm volatile("s_waitcnt lgkmcnt(0)" ::: "memory");
}
__device__ __forceinline__ void convert_weights(ArgP ap, int l, int which, LAS unsigned char* lds, int gw, int NGW, int wid, int lane) {
    LAS float* scr = (LAS float*)(lds + wid * 8704);
    unsigned char* ws = ap->ws;
    constexpr int I_IN = 16 * 269, I_UQ = 4 * 24, I_UKV = 2 * 32, I_BR = 8 * 32, I_OUT = 16 * 32, I_1 = 16 * 128, I_2 = 64 * 32;
    constexpr int I_REST = I_UQ + I_UKV + 4 * I_BR + I_OUT + I_1 + I_2;
    const int BIG = 1 << 30;
    if (which & 1) {
        const float* w_in = (const float*)ap->in[7] + (size_t)l * 1024 * IN_COLS;
        for (int it = gw; it < I_IN; it += NGW) transpose_item(w_in, 1024, IN_COLS, (bf16_t*)(ws + WS_WIN), 2976, 96, scr, it, lane);
        bf16_t* wt = (bf16_t*)(ws + WS_WIN) + (size_t)2976 * 1024; unsigned z = 0u; asm volatile("" : "+v"(z));
        for (int idx = gw * 64 + lane; idx < 96 * 1024 / 8; idx += NGW * 64) *(u32x4*)(wt + (size_t)idx * 8) = (u32x4){z, z, z, z};
    }
    if (which & 2) {
        { const float* sg_w = (const float*)ap->in[9] + (size_t)l * 4 * 128 * 128; bf16_t* o = (bf16_t*)(ws + WS_SGW);
          for (int idx = gw * 64 + lane; idx < 4 * 128 * 128; idx += NGW * 64) { const int t = (idx >> 7) & 127, s = idx & 127; o[idx] = (s <= t) ? f2bf(sg_w[idx]) : (bf16_t)0; } }
        const float* w_uq = (const float*)ap->in[13] + (size_t)l * 256 * 768;
        const float* w_ukv = (const float*)ap->in[15] + (size_t)l * 128 * 1024;
        const float* w_br = (const float*)ap->in[16] + (size_t)l * 4 * 512 * 1024;
        const float* w_out = (const float*)ap->in[17] + (size_t)l * 1024 * 1024;
        const float* w1 = (const float*)ap->in[18] + (size_t)l * 1024 * 4096;
        const float* w2 = (const float*)ap->in[19] + (size_t)l * 4096 * 1024;
        for (int it = gw; it < I_REST; it += NGW) {
            int r = it;
            if (r < I_UQ) { transpose_item(w_uq, 256, 768, (bf16_t*)(ws + WS_WUQ), BIG, 0, scr, r, lane); continue; } r -= I_UQ;
            if (r < I_UKV) { transpose_item(w_ukv, 128, 1024, (bf16_t*)(ws + WS_WUKV), BIG, 0, scr, r, lane); continue; } r -= I_UKV;
            if (r < 4 * I_BR) { const int n = r / I_BR; transpose_item(w_br + (size_t)n * 512 * 1024, 512, 1024, (bf16_t*)(ws + WS_WBR) + (size_t)n * 1024 * 512, BIG, 0, scr, r % I_BR, lane); continue; } r -= 4 * I_BR;
            if (r < I_OUT) { transpose_item(w_out, 1024, 1024, (bf16_t*)(ws + WS_WOUT), BIG, 0, scr, r, lane); continue; } r -= I_OUT;
            if (r < I_1) { transpose_item(w1, 1024, 4096, (bf16_t*)(ws + WS_W1), BIG, 0, scr, r, lane); continue; } r -= I_1;
            transpose_item(w2, 4096, 1024, (bf16_t*)(ws + WS_W2), BIG, 0, scr, r, lane);
        }
    }
}

template <int MODE> __device__ __forceinline__ void norm_row(const float* xrow, const float* g, const float* sc, const float* sh, bf16_t* orow, float* frow, int lane) {
    f32x4 v[4]; float ss = 0.f;
#pragma unroll
    for (int j = 0; j < 4; ++j) { v[j] = ((const f32x4*)xrow)[lane + 64 * j]; ss += (v[j][0] * v[j][0] + v[j][1] * v[j][1]) + (v[j][2] * v[j][2] + v[j][3] * v[j][3]); }
    const float rstd = 1.0f / sqrtf(wave_sum(ss, lane) * (1.f / 1024.f) + NORM_EPS);
#pragma unroll
    for (int j = 0; j < 4; ++j) { const int col = 4 * lane + 256 * j; const f32x4 gv = *(const f32x4*)(g + col);
        if (MODE == 0) { const f32x4 scv = *(const f32x4*)(sc + col), shv = *(const f32x4*)(sh + col); const f32x4 o = (v[j] * rstd) * gv * (1.f + scv) + shv;
            u32x2 w; w.x = pk2(o[0], o[1]); w.y = pk2(o[2], o[3]); *(u32x2*)(orow + col) = w; }
        else { *(f32x4*)(frow + col) = (v[j] * rstd) * gv; } }
}
__device__ __forceinline__ void phase_norm(const float* x, const float* g, const float* mod_l  , int sc_off, int sh_off, bf16_t* H, int gw, int NGW, int MT, int lane) {
    f32x4 v[4], vn[4];
    if (gw < MT) {
#pragma unroll
        for (int j = 0; j < 4; ++j) v[j] = ((const f32x4*)(x + (size_t)gw * 1024))[lane + 64 * j]; }
    for (int m = gw; m < MT; m += NGW) {
        const int mnx = m + NGW;
        if (mnx < MT) {
#pragma unroll
            for (int j = 0; j < 4; ++j) vn[j] = ((const f32x4*)(x + (size_t)mnx * 1024))[lane + 64 * j]; }
        const float* mb = mod_l + (size_t)(m >> 13) * 6144; bf16_t* orow = H + (size_t)m * 1024;
        f32x4 gv[4], scv[4], shv[4];
#pragma unroll
        for (int j = 0; j < 4; ++j) { const int col = 4 * lane + 256 * j; gv[j] = *(const f32x4*)(g + col); scv[j] = *(const f32x4*)(mb + sc_off + col); shv[j] = *(const f32x4*)(mb + sh_off + col); }
        float ss = 0.f;
#pragma unroll
        for (int j = 0; j < 4; ++j) ss += (v[j][0] * v[j][0] + v[j][1] * v[j][1]) + (v[j][2] * v[j][2] + v[j][3] * v[j][3]);
        const float rstd = 1.0f / sqrtf(wave_sum(ss, lane) * (1.f / 1024.f) + NORM_EPS);
#pragma unroll
        for (int j = 0; j < 4; ++j) { const int col = 4 * lane + 256 * j; const f32x4 o = (v[j] * rstd) * gv[j] * (1.f + scv[j]) + shv[j];
            u32x2 w; w.x = pk2(o[0], o[1]); w.y = pk2(o[2], o[3]); *(u32x2*)(orow + col) = w; }
#pragma unroll
        for (int j = 0; j < 4; ++j) v[j] = vn[j];
    }
}

__device__ __forceinline__ s16x4 vtr(const LAS unsigned char* p) { return __builtin_bit_cast(s16x4, __builtin_amdgcn_ds_read_tr16_b64_v4i16((LAS s16x4*)p)); }
__device__ __forceinline__ void sg_unit(int n, int g, const bf16_t* __restrict__ ZA, const bf16_t* __restrict__ SGW, const float* __restrict__ sgn_g, const float* __restrict__ sg_b, bf16_t* __restrict__ Y0,
                                        LAS unsigned char* lds, int tid) {
    const int lane = tid & 63, l31 = lane & 31, hi = lane >> 5, wid = __builtin_amdgcn_readfirstlane(tid >> 6);
    LAS f32x2* stat = (LAS f32x2*)lds; LAS bf16_t* vnT = (LAS bf16_t*)(lds + 1024);
    const int R0 = n * 128;
    { const int s = tid >> 2, cq = tid & 3; const bf16_t* vp = ZA + (size_t)(R0 + s) * ZA_LD + ZA_SGV + cq * 128;
      u32x4 w[16]; float sum = 0.f;
#pragma unroll
      for (int j = 0; j < 16; ++j) w[j] = *(const u32x4*)(vp + 8 * j);
#pragma unroll
      for (int j = 0; j < 16; ++j) { float f[8]; unpack8(w[j], f);
#pragma unroll
          for (int e = 0; e < 8; ++e) sum += f[e]; }
      sum += shx(sum, 1, lane); sum += shx(sum, 2, lane);
      const float mean = sum * (1.f / 512.f); float q = 0.f;
#pragma unroll
      for (int j = 0; j < 16; ++j) { float f[8]; unpack8(w[j], f);
#pragma unroll
          for (int e = 0; e < 8; ++e) { const float d = f[e] - mean; q += d * d; } }
      q += shx(q, 1, lane); q += shx(q, 2, lane);
      if (cq == 0) stat[s] = (f32x2){mean, 1.0f / sqrtf(q * (1.f / 512.f) + NORM_EPS)}; }
    __syncthreads();
    { const int s = tid >> 2, cq = tid & 3; const f32x2 st = stat[s];
#pragma unroll
      for (int j = 0; j < 4; ++j) { const int c = cq * 32 + 8 * j; const u32x4 w = *(const u32x4*)(ZA + (size_t)(R0 + s) * ZA_LD + ZA_SGV + g * 128 + c); float f[8]; unpack8(w, f);
          const f32x4 g0 = *(const f32x4*)(sgn_g + g * 128 + c), g1 = *(const f32x4*)(sgn_g + g * 128 + c + 4);
          u32x4 o; o.x = pk2((f[0] - st.x) * st.y * g0[0], (f[1] - st.x) * st.y * g0[1]); o.y = pk2((f[2] - st.x) * st.y * g0[2], (f[3] - st.x) * st.y * g0[3]);
          o.z = pk2((f[4] - st.x) * st.y * g1[0], (f[5] - st.x) * st.y * g1[1]); o.w = pk2((f[6] - st.x) * st.y * g1[2], (f[7] - st.x) * st.y * g1[3]);
          *(LAS u32x4*)((LAS unsigned char*)vnT + cq * 8192 + s * 64 + 16 * j) = o; } }
    __syncthreads();
    const int tb = wid & 3, cb = wid >> 2;
    f32x16 acc0 = {}, acc1 = {};
    const bf16_t* Wg = SGW + (size_t)(g * 128 + 32 * tb + l31) * 128 + 8 * hi;
    const LAS unsigned char* trp = (const LAS unsigned char*)vnT + (2 * cb) * 8192 + (8 * hi + ((lane & 15) >> 2)) * 64 + ((lane >> 4) & 1) * 32 + (lane & 3) * 8;
    bf16x8 Af[8];
#pragma unroll
    for (int ks = 0; ks < 8; ++ks) Af[ks] = *(const bf16x8*)(Wg + 16 * ks);
    float uv0[16], uv1[16], bsv[16];
#pragma unroll
    for (int r = 0; r < 16; ++r) { const int t = 32 * tb + crow(r, hi); const size_t zo = (size_t)(R0 + t) * ZA_LD + ZA_SGU + g * 128 + 64 * cb + l31;
        uv0[r] = bf2f(ZA[zo]); uv1[r] = bf2f(ZA[zo + 32]); bsv[r] = sg_b[g * 128 + t]; }
#pragma unroll
    for (int ks = 0; ks < 8; ++ks) {
        const s16x4 b0l = vtr(trp + ks * 1024), b0h = vtr(trp + ks * 1024 + 256), b1l = vtr(trp + 8192 + ks * 1024), b1h = vtr(trp + 8192 + ks * 1024 + 256);
        const bf16x8 B0 = __builtin_shufflevector(b0l, b0h, 0, 1, 2, 3, 4, 5, 6, 7), B1 = __builtin_shufflevector(b1l, b1h, 0, 1, 2, 3, 4, 5, 6, 7);
        acc0 = MFMA32(Af[ks], B0, acc0); acc1 = MFMA32(Af[ks], B1, acc1);
    }
#pragma unroll
    for (int r = 0; r < 16; ++r) { const int t = 32 * tb + crow(r, hi), row = R0 + t; const int c = g * 128 + 64 * cb + l31;
        Y0[(size_t)row * 512 + c] = f2bf(uv0[r] * (acc0[r] + bsv[r])); Y0[(size_t)row * 512 + c + 32] = f2bf(uv1[r] * (acc1[r] + bsv[r])); }
    __syncthreads();
}
__device__ __forceinline__ void conv_item(int item, const bf16_t* __restrict__ ZA, const float* __restrict__ cw  , bf16_t* __restrict__ Y1, int tid) {
    const int idx = item * 512 + tid, row = idx >> 6, c = (idx & 63) * 8, s = row & (SEQ - 1);
    float gb[8], acc[8]; unpack8(*(const u32x4*)(ZA + (size_t)row * ZA_LD + ZA_CB + c), gb);
#pragma unroll
    for (int e = 0; e < 8; ++e) acc[e] = 0.f;
#pragma unroll
    for (int k = 0; k < 3; ++k) { const int d = 2 - k; if (s - d >= 0) { const size_t rr = (size_t)(row - d) * ZA_LD; float gc[8], xv[8]; unpack8(*(const u32x4*)(ZA + rr + ZA_CC + c), gc); unpack8(*(const u32x4*)(ZA + rr + ZA_CX + c), xv);
#pragma unroll
            for (int e = 0; e < 8; ++e) acc[e] += cw[k * 512 + c + e] * (gc[e] * xv[e]); } }
    u32x4 o; o.x = pk2(gb[0] * acc[0], gb[1] * acc[1]); o.y = pk2(gb[2] * acc[2], gb[3] * acc[3]); o.z = pk2(gb[4] * acc[4], gb[5] * acc[5]); o.w = pk2(gb[6] * acc[6], gb[7] * acc[7]);
    *(u32x4*)(Y1 + (size_t)row * 512 + c) = o;
}
__device__ __forceinline__ void mlaprep_row(int row, const bf16_t* __restrict__ ZA, const float* __restrict__ gq, const float* __restrict__ gkv, const float* __restrict__ COS, const float* __restrict__ SIN,
                                            bf16_t* __restrict__ CQN, bf16_t* __restrict__ CKVN, bf16_t* __restrict__ KPE, int lane) {
    const bf16_t* z = ZA + (size_t)row * ZA_LD;
    const u32x2 wq = *(const u32x2*)(z + ZA_CQ + 4 * lane); const unsigned wkv = *(const unsigned*)(z + ZA_CKV + 2 * lane);
    const f32x4 g4 = *(const f32x4*)(gq + 4 * lane); const float gk0 = gkv[2 * lane], gk1 = gkv[2 * lane + 1];
    const int l16 = lane & 15; const float x1 = bf2f(z[ZA_KPE + l16]), x2 = bf2f(z[ZA_KPE + 16 + l16]); const float c = COS[(size_t)row * 16 + l16], s = SIN[(size_t)row * 16 + l16];
    { const float f0 = bf2f(wq.x & 0xffffu), f1 = bf2f(wq.x >> 16), f2 = bf2f(wq.y & 0xffffu), f3 = bf2f(wq.y >> 16);
      const float rstd = 1.0f / sqrtf(wave_sum((f0 * f0 + f1 * f1) + (f2 * f2 + f3 * f3), lane) * (1.f / 256.f) + NORM_EPS);
      u32x2 o; o.x = pk2(f0 * rstd * g4[0], f1 * rstd * g4[1]); o.y = pk2(f2 * rstd * g4[2], f3 * rstd * g4[3]); *(u32x2*)(CQN + (size_t)row * 256 + 4 * lane) = o; }
    { const float f0 = bf2f(wkv & 0xffffu), f1 = bf2f(wkv >> 16);
      const float rstd = 1.0f / sqrtf(wave_sum(f0 * f0 + f1 * f1, lane) * (1.f / 128.f) + NORM_EPS);
      *(unsigned*)(CKVN + (size_t)row * 128 + 2 * lane) = pk2(f0 * rstd * gk0, f1 * rstd * gk1); }
    if (lane < 16) { KPE[(size_t)row * 32 + lane] = f2bf(x1 * c - x2 * s); KPE[(size_t)row * 32 + 16 + lane] = f2bf(x2 * c + x1 * s); }
}

__device__ __forceinline__ bf16x8 pack8(const f32x16& x, int b) {
    u32x4 p; p.x = pk2(x[b], x[b + 1]); p.y = pk2(x[b + 2], x[b + 3]); p.z = pk2(x[b + 4], x[b + 5]); p.w = pk2(x[b + 6], x[b + 7]); return __builtin_bit_cast(bf16x8, p);
}
#define PV_STEP(O0_, O1_, pf_, vtp_) do { s16x4 vl_[8], vh_[8]; \
        _Pragma("unroll") for (int ks_ = 0; ks_ < 4; ++ks_) { vl_[ks_] = vtr((vtp_) + ks_ * 1024); vh_[ks_] = vtr((vtp_) + ks_ * 1024 + 512); vl_[4 + ks_] = vtr((vtp_) + 4096 + ks_ * 1024); vh_[4 + ks_] = vtr((vtp_) + 4096 + ks_ * 1024 + 512); } \
        __builtin_amdgcn_sched_barrier(0); \
        _Pragma("unroll") for (int ks_ = 0; ks_ < 4; ++ks_) { \
        const bf16x8 v0_ = __builtin_shufflevector(vl_[ks_], vh_[ks_], 0, 1, 2, 3, 4, 5, 6, 7), v1_ = __builtin_shufflevector(vl_[4 + ks_], vh_[4 + ks_], 0, 1, 2, 3, 4, 5, 6, 7); \
        O0_ = MFMA32((pf_)[ks_], v0_, O0_); O1_ = MFMA32((pf_)[ks_], v1_, O1_); } } while (0)

__device__ __forceinline__ void mla_unit(int b, int h, int qb, const bf16_t* __restrict__ QM, const bf16_t* __restrict__ KVM, const bf16_t* __restrict__ KPE, bf16_t* __restrict__ YO, LAS unsigned char* lds, int tid) {
    const int lane = tid & 63, l31 = lane & 31, hi = lane >> 5, wid = __builtin_amdgcn_readfirstlane(tid >> 6);
    const int rowbase = b * SEQ, q0 = qb * 256, qw0 = q0 + 32 * wid, qrow = qw0 + l31;
    constexpr int MLA_BUF = 22528;
    LAS unsigned char* KS = lds; LAS unsigned char* VS = lds + 14336; LAS float* wsf = (LAS float*)(lds + 2 * MLA_BUF) + wid * 64;
    bf16x8 qf[6];
    { const bf16_t* qp = QM + (size_t)(rowbase + qrow) * 768 + 96 * h + 8 * hi;
#pragma unroll
      for (int d0 = 0; d0 < 6; ++d0) qf[d0] = *(const bf16x8*)(qp + 16 * d0); }
    const int krA = tid / 12, kpA = tid % 12, krB = (tid + 512) / 12, kpB = (tid + 512) % 12, vr = tid >> 3, vp = tid & 7;
    const bf16_t* srcA = (kpA < 8) ? KVM + (size_t)(rowbase + krA) * 1024 + 128 * h + 8 * kpA : KPE + (size_t)(rowbase + krA) * 32 + 8 * (kpA - 8);
    const bf16_t* srcB = (kpB < 8) ? KVM + (size_t)(rowbase + krB) * 1024 + 128 * h + 8 * kpB : KPE + (size_t)(rowbase + krB) * 32 + 8 * (kpB - 8);
    const size_t stA = (kpA < 8) ? 64 * 1024 : 64 * 32, stB = (kpB < 8) ? 64 * 1024 : 64 * 32;
    const bf16_t* srcV = KVM + (size_t)(rowbase + vr) * 1024 + 128 * h + 64 + 8 * vp;
    LAS unsigned char* dstA = KS + krA * 224 + kpA * 16; LAS unsigned char* dstB = KS + krB * 224 + kpB * 16; LAS unsigned char* dstV = VS + (vp >> 2) * 4096 + vr * 64 + (vp & 3) * 16;
    const LAS unsigned char* kfp = KS + l31 * 224 + 16 * hi;
    const LAS unsigned char* vtp = VS + ((lane >> 4) & 1) * 32 + (lane & 3) * 8 + (4 * hi + ((lane & 15) >> 2)) * 64;
    const int NT = 4 * qb + 4;
    float m = 0.f, l = 0.f; f32x16 O0 = {}, O1 = {};
    f32x16 negm = {};
    u32x4 ka, kb = {0u, 0u, 0u, 0u}, vv;
    ka = *(const u32x4*)srcA; if (tid < 256) kb = *(const u32x4*)srcB; vv = *(const u32x4*)srcV;
    *(LAS u32x4*)dstA = ka; if (tid < 256) *(LAS u32x4*)dstB = kb; *(LAS u32x4*)dstV = vv;
    { ka = *(const u32x4*)(srcA + stA); if (tid < 256) kb = *(const u32x4*)(srcB + stB); vv = *(const u32x4*)(srcV + (size_t)64 * 1024); }
    for (int t = 0; t < NT; ++t) {
        const int cur = (t & 1) * MLA_BUF, nxt = MLA_BUF - cur;
        __syncthreads();
        if (t + 1 < NT) { *(LAS u32x4*)(dstA + nxt) = ka; if (tid < 256) *(LAS u32x4*)(dstB + nxt) = kb; *(LAS u32x4*)(dstV + nxt) = vv; }
        if (t + 2 < NT) { ka = *(const u32x4*)(srcA + (size_t)(t + 2) * stA); if (tid < 256) kb = *(const u32x4*)(srcB + (size_t)(t + 2) * stB); vv = *(const u32x4*)(srcV + (size_t)(t + 2) * 64 * 1024); }
        if (64 * t <= qw0 + 31) {
            f32x16 S0, S1;
#pragma unroll
            for (int d0 = 0; d0 < 6; ++d0) { const bf16x8 k0 = *(const LAS bf16x8*)(kfp + cur + 32 * d0), k1 = *(const LAS bf16x8*)(kfp + cur + 32 * 224 + 32 * d0);
                S0 = MFMA32(k0, qf[d0], d0 == 0 ? negm : S0); S1 = MFMA32(k1, qf[d0], d0 == 0 ? negm : S1); }
            if (64 * t + 63 > qw0) {
#pragma unroll
                for (int r = 0; r < 16; ++r) { const int kv = 64 * t + crow(r, hi); if (kv > qrow) S0[r] = -INFINITY; if (kv + 32 > qrow) S1[r] = -INFINITY; }
            }
            float mxa = max3f(S0[0], S0[1], S1[0]), mxb = max3f(S0[2], S0[3], S1[1]); mxa = max3f(mxa, S1[2], S1[3]);
#pragma unroll
            for (int r = 4; r < 16; r += 4) { mxa = max3f(mxa, S0[r], S0[r + 1]); mxb = max3f(mxb, S0[r + 2], S0[r + 3]); mxa = max3f(mxa, S1[r], S1[r + 1]); mxb = max3f(mxb, S1[r + 2], S1[r + 3]); }
            float mx = max2f(mxa, mxb);
            mx = max2f(mx, shx(mx, 32, lane));
            if (t == 0 || __any(mx > 0.f)) {
                const float d = (t == 0) ? mx : max2f(mx, 0.f);
#pragma unroll
                for (int r = 0; r < 16; ++r) { S0[r] -= d; S1[r] -= d; }
                m += d;
#pragma unroll
                for (int r = 0; r < 16; ++r) negm[r] = -m;
                if (t > 0) { const float alpha = fexp2(-d); l *= alpha;
                    if (hi == 0) wsf[l31] = alpha;
#pragma unroll
                    for (int r = 0; r < 16; ++r) { const float al = wsf[crow(r, hi)]; O0[r] *= al; O1[r] *= al; } }
            }
            float ps = 0.f;
#pragma unroll
            for (int r = 0; r < 16; ++r) { S0[r] = fexp2(S0[r]); S1[r] = fexp2(S1[r]); ps += S0[r] + S1[r]; }
            l += ps;
            bf16x8 pf[4]; pf[0] = pack8(S0, 0); pf[1] = pack8(S0, 8); pf[2] = pack8(S1, 0); pf[3] = pack8(S1, 8);
            const LAS unsigned char* vt = vtp + cur;
            PV_STEP(O0, O1, pf, vt);
        }
    }
    const float lt = l + shx(l, 32, lane);
    if (hi == 0) wsf[l31] = 1.0f / lt;
#pragma unroll
    for (int r = 0; r < 16; ++r) { const float inv = wsf[crow(r, hi)]; bf16_t* o = YO + (size_t)(rowbase + qw0 + crow(r, hi)) * 512 + 64 * h + l31; o[0] = f2bf(O0[r] * inv); o[32] = f2bf(O1[r] * inv); }
    __syncthreads();
}

__device__ __forceinline__ void sb_unit(int b, int h, int qb, const bf16_t* __restrict__ ZA, bf16_t* __restrict__ YO, LAS unsigned char* lds, int tid) {
    const int lane = tid & 63, l31 = lane & 31, hi = lane >> 5, wid = __builtin_amdgcn_readfirstlane(tid >> 6);
    const int rowbase = b * SEQ, q0 = qb * 256, qw0 = q0 + 32 * wid, qrow = qw0 + l31;
    LAS unsigned char* KS = lds; LAS unsigned char* VS = lds + 9216; volatile LAS int* flags = (volatile LAS int*)(lds + 17408);
    bf16x8 qf[4];
    { const bf16_t* qp = ZA + (size_t)(rowbase + qrow) * ZA_LD + ZA_SBQ + 64 * h + 8 * hi;
#pragma unroll
      for (int d0 = 0; d0 < 4; ++d0) qf[d0] = *(const bf16x8*)(qp + 16 * d0); }
    const int vr = tid >> 3, vp = tid & 7;
    const bf16_t* srcK = ZA + (size_t)(rowbase + vr) * ZA_LD + ZA_SBK + 64 * h + 8 * vp; const bf16_t* srcV = srcK + (ZA_SBV - ZA_SBK);
    LAS unsigned char* dstK = KS + vr * 144 + vp * 16; LAS unsigned char* dstV = VS + (vp >> 2) * 4096 + vr * 64 + (vp & 3) * 16;
    const LAS unsigned char* kfp = KS + l31 * 144 + 16 * hi;
    const LAS unsigned char* vtp = VS + ((lane >> 4) & 1) * 32 + (lane & 3) * 8 + (4 * hi + ((lane & 15) >> 2)) * 64;
    bf16x8 tri0, tri1, ones;
#pragma unroll
    for (int j = 0; j < 8; ++j) { const int k0 = 8 * (j >> 2) + 4 * hi + (j & 3); tri0[j] = (k0 > l31) ? (short)0x3F80 : (short)0; tri1[j] = (16 + k0 > l31) ? (short)0x3F80 : (short)0; ones[j] = (short)0x3F80; }
    const int NT = 4 * qb + 4;
    float R = 0.f; f32x16 O0 = {}, O1 = {};
    if (tid < 8) flags[tid] = 0;
    int done = 0;
    u32x4 kk, vv;
    kk = *(const u32x4*)(srcK + (size_t)(NT - 1) * 64 * ZA_LD); vv = *(const u32x4*)(srcV + (size_t)(NT - 1) * 64 * ZA_LD);
    for (int t = NT - 1; t >= 0; --t) {
        __syncthreads();
        { int f = 1;
#pragma unroll
          for (int i = 0; i < 8; ++i) f &= flags[i];
          if (f) break; }
        *(LAS u32x4*)dstK = kk; *(LAS u32x4*)dstV = vv;
        __syncthreads();
        if (t > 0) { kk = *(const u32x4*)(srcK + (size_t)(t - 1) * 64 * ZA_LD); vv = *(const u32x4*)(srcV + (size_t)(t - 1) * 64 * ZA_LD); }
        if (64 * t < qw0 + 31 && !done) {
            f32x16 S0 = {}, S1 = {};
            bf16x8 kf0[4], kf1[4];
#pragma unroll
            for (int d0 = 0; d0 < 4; ++d0) { kf0[d0] = *(const LAS bf16x8*)(kfp + 32 * d0); kf1[d0] = *(const LAS bf16x8*)(kfp + 32 * 144 + 32 * d0); }
            __builtin_amdgcn_sched_barrier(0);
#pragma unroll
            for (int d0 = 0; d0 < 4; ++d0) { S0 = MFMA32(kf0[d0], qf[d0], S0); S1 = MFMA32(kf1[d0], qf[d0], S1); }
            const bool diag = (64 * t + 63 >= qw0);
            f32x16 X0, X1;
#pragma unroll
            for (int r = 0; r < 16; ++r) {
                const int kv = 64 * t + crow(r, hi);
                { const float z = S0[r]; const float sp = fmaxf(z, 0.f) + flog2(1.f + fexp2(-fabsf(z))); const bool ok = !diag || (kv < qrow); X0[r] = ok ? -sp : 0.f; S0[r] = ok ? (z - sp) : -INFINITY; }
                { const float z = S1[r]; const float sp = fmaxf(z, 0.f) + flog2(1.f + fexp2(-fabsf(z))); const bool ok = !diag || (kv + 32 < qrow); X1[r] = ok ? -sp : 0.f; S1[r] = ok ? (z - sp) : -INFINITY; }
            }
            bf16x8 xb[4]; xb[0] = pack8(X0, 0); xb[1] = pack8(X0, 8); xb[2] = pack8(X1, 0); xb[3] = pack8(X1, 8);
            f32x16 Rv;
#pragma unroll
            for (int r = 0; r < 16; ++r) Rv[r] = R;
            f32x16 Y0 = MFMA32(tri0, xb[0], Rv); Y0 = MFMA32(tri1, xb[1], Y0); Y0 = MFMA32(ones, xb[2], Y0); Y0 = MFMA32(ones, xb[3], Y0);
            f32x16 Y1 = MFMA32(tri0, xb[2], Rv); Y1 = MFMA32(tri1, xb[3], Y1);
            const float Rn = Y0[0] + X0[0];
            R = shl(Rn, l31);
#pragma unroll
            for (int r = 0; r < 16; ++r) { S0[r] = fexp2(S0[r] + Y0[r]); S1[r] = fexp2(S1[r] + Y1[r]); }
            bf16x8 pf[4]; pf[0] = pack8(S0, 0); pf[1] = pack8(S0, 8); pf[2] = pack8(S1, 0); pf[3] = pack8(S1, 8);
            PV_STEP(O0, O1, pf, vtp);
            done = __all(R < -150.1f);
        }
        if (lane == 0) flags[wid] = done;
    }
#pragma unroll
    for (int r = 0; r < 16; ++r) { bf16_t* o = YO + (size_t)(rowbase + qw0 + crow(r, hi)) * 512 + 64 * h + l31; o[0] = f2bf(O0[r]); o[32] = f2bf(O1[r]); }
    __syncthreads();
}
#define XB_TMO      128
#define XB_XCNT(j)  (256  + 64 * (j))
#define XB_XSUB(j)  (1280 + 64 * (j))
#define XB_XGEN(j)  (2304 + 64 * (j))
#define XB_TOP      3328
#define XB_TOPGEN   3392
#define XCD_BAR_WORDS 3456
#define XB_SPIN_CAP (1u << 18)

__device__ __forceinline__ unsigned xb_ld(unsigned* p)              { return __hip_atomic_load(p, __ATOMIC_RELAXED, __HIP_MEMORY_SCOPE_AGENT); }
__device__ __forceinline__ unsigned xb_add(unsigned* p, unsigned v) { return __hip_atomic_fetch_add(p, v, __ATOMIC_RELAXED, __HIP_MEMORY_SCOPE_AGENT); }
__device__ __forceinline__ unsigned xb_xcc_id() { return (unsigned)__builtin_amdgcn_s_getreg((3 << 11) | 20) & 0xFu; }
#define XB_SPIN(cond, bar) do { unsigned _sp = 0; while (cond) { __builtin_amdgcn_s_sleep(1); \
    if ((++_sp & 255u) == 0u) { if (xb_ld(&(bar)[XB_TMO])) break; if (_sp > XB_SPIN_CAP) { atomicAdd(&(bar)[XB_TMO], 1u); break; } } } } while (0)

struct XcdBarrier {
    unsigned* bar; unsigned x;
    volatile LAS unsigned* st;
};

__device__ __forceinline__ XcdBarrier xcd_barrier_post(unsigned* bar, volatile LAS unsigned* st) {
    XcdBarrier b; b.bar = bar; b.x = xb_xcc_id(); b.st = st;
    if (threadIdx.x == 0) st[2] = xb_add(&bar[XB_XCNT(b.x)], 1u);
    return b;
}
__device__ __forceinline__ void xcd_barrier_complete(unsigned* bar, unsigned x, unsigned& nloc, unsigned& nx) {
    const unsigned G = gridDim.x * gridDim.y * gridDim.z;
    unsigned sum, cnt, mine, sp = 0u;
    for (;;) {
        sum = 0u; cnt = 0u; mine = 0u;
#pragma unroll
        for (unsigned j = 0; j < 16; ++j) { const unsigned c = xb_ld(&bar[XB_XCNT(j)]); sum += c; cnt += (c > 0u) ? 1u : 0u; mine = (j == x) ? c : mine; }
        if (sum == G) break;
        __builtin_amdgcn_s_sleep(1);
        if ((++sp & 255u) == 0u) { if (xb_ld(&bar[XB_TMO])) break; if (sp > XB_SPIN_CAP) { atomicAdd(&bar[XB_TMO], 1u); break; } }
    }
    nloc = mine > 0u ? mine : 1u; nx = cnt > 0u ? cnt : 1u;
}

__device__ __forceinline__ void xcd_barrier(const XcdBarrier& b) {
    asm volatile("s_waitcnt vmcnt(0)" ::: "memory");
    __syncthreads();
    if (threadIdx.x == 0) {
        unsigned* bar = b.bar;
        __builtin_amdgcn_s_waitcnt(0);
        unsigned nloc = b.st[0], nx = b.st[1];
        if (nloc == 0u) { xcd_barrier_complete(bar, b.x, nloc, nx); b.st[0] = nloc; b.st[1] = nx; }
        const unsigned old = xb_add(&bar[XB_XSUB(b.x)], 1u);
        const unsigned gen = old / nloc;
        if (old + 1u == (gen + 1u) * nloc) {
            __builtin_amdgcn_fence(__ATOMIC_RELEASE, "agent");
            asm volatile("s_waitcnt vmcnt(0)" ::: "memory");
            const unsigned og = xb_add(&bar[XB_TOP], 1u);
            const unsigned tg = og / nx;
            if (og + 1u == (tg + 1u) * nx) xb_add(&bar[XB_TOPGEN], 1u);
            else XB_SPIN(xb_ld(&bar[XB_TOPGEN]) == tg, bar);
            __builtin_amdgcn_fence(__ATOMIC_ACQUIRE, "agent");
            xb_add(&bar[XB_XGEN(b.x)], 1u);
            asm volatile("s_waitcnt vmcnt(0)" ::: "memory");
        } else {
            XB_SPIN(xb_ld(&bar[XB_XGEN(b.x)]) == gen, bar);
            __builtin_amdgcn_fence(__ATOMIC_ACQUIRE, "agent");
            asm volatile("s_waitcnt vmcnt(0)" ::: "memory");
        }
    }
    __syncthreads();
}

#define XL_CNT(j)  (3584 + 64 * (j))
#define XL_GEN(j)  (4608 + 64 * (j))
__device__ __forceinline__ void xcd_local_barrier(const XcdBarrier& b, unsigned nloc) {
    asm volatile("s_waitcnt vmcnt(0)" ::: "memory");
    __syncthreads();
    if (threadIdx.x == 0) {
        unsigned* bar = b.bar;
        const unsigned n = b.st[5] + 1u; b.st[5] = n;
        const unsigned target = n * nloc;
        (void)xb_add(&bar[XL_CNT(b.x)], 1u);
        XB_SPIN(xb_ld(&bar[XL_CNT(b.x)]) < target, bar);
        __builtin_amdgcn_fence(__ATOMIC_ACQUIRE, "agent");
        asm volatile("s_waitcnt vmcnt(0)" ::: "memory");
    }
    __syncthreads();
}

#define XP_CNT(pm) (5632 + 64 * (pm))
__device__ __forceinline__ void panel_sync(const XcdBarrier& b, int pm) {
    asm volatile("s_waitcnt vmcnt(0)" ::: "memory");
    __syncthreads();
    if (threadIdx.x == 0) {
        unsigned* bar = b.bar;
        const unsigned n = b.st[6] + 1u; b.st[6] = n;
        (void)xb_add(&bar[XP_CNT(pm)], 1u);
        XB_SPIN(xb_ld(&bar[XP_CNT(pm)]) < 4u * n, bar);
        __builtin_amdgcn_fence(__ATOMIC_ACQUIRE, "agent");
        asm volatile("s_waitcnt vmcnt(0)" ::: "memory");
    }
    __syncthreads();
}

__global__ void __launch_bounds__(512, 2) trunk_fwd(Args a_) {
    extern __shared__ __attribute__((aligned(16))) unsigned char lds_raw[];
    LAS unsigned char* lds = (LAS unsigned char*)lds_raw;
    cg::grid_group grid = cg::this_grid();
    const int G = gridDim.x;
    const int wid0 = __builtin_amdgcn_readfirstlane(threadIdx.x >> 6);
    using namespace pg8;

    const int ph_lo = a_.ph_lo, ph_hi = a_.ph_hi;
    { volatile LAS unsigned* stw = (volatile LAS unsigned*)(lds + 131072); if (threadIdx.x < 8) stw[threadIdx.x] = 0u; }
    __syncthreads();
    XcdBarrier xbar = xcd_barrier_post((unsigned*)(a_.ws + WS_CTL), (volatile LAS unsigned*)(lds + 131072));
    for (int ph = ph_lo; ph < ph_hi; ++ph) {
        int bx = blockIdx.x, wid = wid0; asm volatile("" : "+s"(bx), "+s"(wid));
#define LANE_TID const int lane = fresh_lane(), tid = wid * 64 + lane; (void)tid
        volatile LAS unsigned* stw = (volatile LAS unsigned*)(lds + 131072);
        const bool xloc = (__builtin_amdgcn_readfirstlane((int)stw[3]) == 1);
        if (xloc) bx = __builtin_amdgcn_readfirstlane((int)(stw[2] * 8u + xbar.x));
        const int vcu = (G % 8 == 0) ? (bx % 8) * (G / 8) + bx / 8 : bx;
        const int gw = vcu * 8 + wid, NGW = G * 8;
        ArgP ap = (ArgP)__builtin_amdgcn_kernarg_segment_ptr(); asm volatile("" : "+s"(ap));
        unsigned char* ws = ap->ws;
        float* MOD = (float*)(ws + WS_MOD);
        bf16_t* H = (bf16_t*)(ws + WS_H); bf16_t* ZA = (bf16_t*)(ws + WS_ZA); bf16_t* ZG = (bf16_t*)(ws + WS_ZG); bf16_t* YS = (bf16_t*)(ws + WS_YS);
        bf16_t* CQN = (bf16_t*)(ws + WS_CQN); bf16_t* CKVN = (bf16_t*)(ws + WS_CKVN); bf16_t* KPE = (bf16_t*)(ws + WS_KPE); bf16_t* QM = (bf16_t*)(ws + WS_QM); bf16_t* KVM = (bf16_t*)(ws + WS_KVM);
        bf16_t* MGB = (bf16_t*)(ws + WS_MGB); bf16_t* HMID = (bf16_t*)(ws + WS_HMID);
        const float* COS = (const float*)(ws + WS_COS); const float* SIN = (const float*)(ws + WS_SIN);
        const float* xin0 = (const float*)ap->in[0];
        if (ph == 0) { LANE_TID; convert_weights(ap, 0, 1, lds, gw, NGW, wid, lane); __syncthreads(); phase_prologue(ap, vcu, G, gw, NGW, wid, lane, lds); }
        else if (ph == 1) continue;
        else if (ph == NPH - 1) {
            if (xloc && G == 256) continue;
            LANE_TID; const float* g = (const float*)ap->in[20];
            const int nb = xloc ? 2048 * (bx & 7) + (bx >> 3) * 8 + wid : gw, ns = xloc ? 256 : NGW, nl = xloc ? 2048 * ((bx & 7) + 1) : MT;
            for (int m = nb; m < nl; m += ns) norm_row<1>(ap->out + (size_t)m * 1024, g, nullptr, nullptr, nullptr, ap->out + (size_t)m * 1024, lane);
        } else {
            const int l = (ph - 2) / 10, k = (ph - 2) % 10;
            const bool fuse = xloc && (G == 256);
            if (fuse && (k == 7 || (k == 0 && l > 0))) continue;
            const float* modl = MOD + (size_t)l * 2 * 6144;
            const float* xcur = (l == 0) ? xin0 : ap->out;
            switch (k) {
            case 0: {
                LANE_TID;
                const int r0 = (8 * (bx & 7) + ((bx >> 3) & 7)) * 256 + (bx >> 6) * 64;
                const int nb = fuse ? r0 + wid : (xloc ? 2048 * (bx & 7) + (bx >> 3) * 8 + wid : gw), ns = fuse ? 8 : (xloc ? 256 : NGW), nl = fuse ? r0 + 64 : (xloc ? 2048 * ((bx & 7) + 1) : MT);
                phase_norm(xcur, (const float*)ap->in[5] + l * 1024, modl, 1024, 0, H, nb, ns, nl, lane);
            } break;
            case 1: {
                Gemm g{H, (const bf16_t*)(ws + WS_WIN), MT, NPAD, 1024, 1024, 1024}; StaticOrder S; S.init(MT, NPAD, G, bx);
                EpiInProj E{ZA, ZG};
                gemm_phase<EpiInProj, StaticOrder, false, true>(lds, g, S, E, fresh_tid(wid));
                { const int nfull = (MT / 256) * (NPAD / 256) % G; const int nb = (nfull == 0) ? G : G - nfull, b0 = (nfull == 0) ? 0 : nfull;
                  if (bx >= b0) { __syncthreads(); const int lane = fresh_lane(); convert_weights(ap, l, 2, lds, (bx - b0) * 8 + wid, nb * 8, wid, lane); } }
            } break;
            case 2: {
                LANE_TID;
                const float* sgn_g = (const float*)ap->in[8] + l * 512; const float* sg_b = (const float*)ap->in[10] + l * 512; const float* cw = (const float*)ap->in[11] + l * 1536;
                const float* gq = (const float*)ap->in[12] + l * 256; const float* gkv = (const float*)ap->in[14] + l * 128;
                { const int r0 = (8 * (bx & 7) + ((bx >> 3) & 7)) * 256 + (bx >> 6) * 64;
                  const int nb = fuse ? r0 + wid : (xloc ? 2048 * (bx & 7) + (bx >> 3) * 8 + wid : gw), ns = fuse ? 8 : (xloc ? 256 : NGW), nl = fuse ? r0 + 64 : (xloc ? 2048 * ((bx & 7) + 1) : MT);
                  for (int m = nb; m < nl; m += ns) mlaprep_row(m, ZA, gq, gkv, COS, SIN, CQN, CKVN, KPE, lane); }
                for (int u = vcu; u < 512 + 2048; u += G) {
                    if (u < 512) sg_unit(u >> 2, u & 3, ZA, (const bf16_t*)(ws + WS_SGW), sgn_g, sg_b, YS, lds, tid);
                    else conv_item(u - 512, ZA, cw, YS + (size_t)MT * 512, tid);
                }
                if (l + 1 < NL) { __syncthreads(); convert_weights(ap, l + 1, 1, lds, gw, NGW, wid, lane); }
            } break;
            case 3: {
                { Gemm g{CQN, (const bf16_t*)(ws + WS_WUQ), MT, 768, 256, 256, 256}; StaticOrder S; S.init(MT, 768, G, bx);
                  EpiMlaQ E{QM, COS, SIN, 0.10206207261596575f * LOG2E};
                  gemm_phase<EpiMlaQ, StaticOrder, true, true>(lds, g, S, E, fresh_tid(wid)); }
                { Gemm g{CKVN, (const bf16_t*)(ws + WS_WUKV), MT, 1024, 128, 128, 128}; StaticOrder S; S.init(MT, 1024, G, bx);
                  EpiBf16<0> E{KVM, 1024};
                  gemm_phase<EpiBf16<0>, StaticOrder, true, true>(lds, g, S, E, fresh_tid(wid)); }
            } break;
            case 4: {
                LANE_TID;
                for (int p = vcu; p < 256; p += G) {
                    const int bh = p >> 4, s = p & 15, b = bh >> 3, h = bh & 7;
                    mla_unit(b, h, 31 - s, QM, KVM, KPE, YS + (size_t)2 * MT * 512, lds, tid);
                    mla_unit(b, h, s, QM, KVM, KPE, YS + (size_t)2 * MT * 512, lds, tid);
                    sb_unit(b, h, 31 - s, ZA, YS + (size_t)3 * MT * 512, lds, tid);
                    sb_unit(b, h, s, ZA, YS + (size_t)3 * MT * 512, lds, tid);
                }
            } break;
            case 5: {
                Gemm g{YS, (const bf16_t*)(ws + WS_WBR), 4 * MT, 4 * 1024, 512, 512, 512}; BranchOrder S; S.so.init(MT, 1024, G, bx);
                EpiBranch E{ZG, MGB};
                gemm_phase<EpiBranch, BranchOrder, false, true>(lds, g, S, E, fresh_tid(wid));
            } break;
            case 8: {
                Gemm g{H, (const bf16_t*)(ws + WS_W1), MT, DFF, 1024, 1024, 1024}; StaticOrder S; S.init(MT, DFF, G, bx);
                EpiBf16<4> E{HMID, DFF};
                gemm_phase<EpiBf16<4>, StaticOrder, true, true>(lds, g, S, E, fresh_tid(wid));
            } break;
            case 7: {
                LANE_TID;
                const int nb = xloc ? 2048 * (bx & 7) + (bx >> 3) * 8 + wid : gw, ns = xloc ? 256 : NGW, nl = xloc ? 2048 * ((bx & 7) + 1) : MT;
                phase_norm(ap->out, (const float*)ap->in[6] + l * 1024, modl, 4096, 3072, H, nb, ns, nl, lane);
            } break;
            default: {
                const bool mix = (k == 6); const int K = mix ? 1024 : DFF;
                Gemm g{mix ? MGB : HMID, (const bf16_t*)(ws + (mix ? WS_WOUT : WS_W2)), MT, 1024, K, K, K}; StaticOrder S; S.init(MT, 1024, G, bx);
                EpiResid E{mix ? xcur : ap->out, ap->out, modl + (mix ? 2048 : 5120)};
                gemm_phase<EpiResid, StaticOrder, true, true>(lds, g, S, E, fresh_tid(wid));
                if (fuse) {
                    Unit u0; (void)S.next(0, u0);
                    panel_sync(xbar, u0.pm);
                    const int lane = fresh_lane(); const int r0 = u0.pm * 256 + u0.pn * 64;
                    if (mix) phase_norm(ap->out, (const float*)ap->in[6] + l * 1024, modl, 4096, 3072, H, r0 + wid, 8, r0 + 64, lane);
                    else if (l + 1 < NL) phase_norm(ap->out, (const float*)ap->in[5] + (l + 1) * 1024, MOD + (size_t)(l + 1) * 2 * 6144, 1024, 0, H, r0 + wid, 8, r0 + 64, lane);
                    else { const float* gf = (const float*)ap->in[20]; for (int m = r0 + wid; m < r0 + 64; m += 8) norm_row<1>(ap->out + (size_t)m * 1024, gf, nullptr, nullptr, nullptr, ap->out + (size_t)m * 1024, lane); }
                }
            } break;
            }
        }
        if (ph + 1 < ph_hi) {
            if (ph == ph_lo) {
                grid.sync();
                if (threadIdx.x == 0) { unsigned ok = (G % 8 == 0) ? 1u : 0u, npop = 0u;
                    for (unsigned j = 0; j < 16; ++j) { const unsigned c = xb_ld(&xbar.bar[XB_XCNT(j)]); if (c) { ++npop; if (c != (unsigned)G / 8u) ok = 0u; } }
                    stw[3] = (ok && npop == 8u) ? 1u : 2u; }
                __syncthreads();
            } else {
                const int kk = (ph >= 2 && ph < NPH - 1) ? (ph - 2) % 10 : -1;
                const bool fuse_s = xloc && (G == 256);
                const int my_pm = 8 * (bx & 7) + ((bx >> 3) & 7);
                if (fuse_s && kk == 9 && ph + 2 >= NPH - 1) { }
                else if (fuse_s && (kk == 0 || kk == 2 || kk == 5 || kk == 6 || kk == 8 || kk == 9)) panel_sync(xbar, my_pm);
                else if (xloc && (kk == 0 || kk == 2 || kk >= 5)) xcd_local_barrier(xbar, (unsigned)G / 8u); else xcd_barrier(xbar);
            }
        }
    }
}

#ifndef N_LAUNCH_MODE
#define N_LAUNCH_MODE 1
#endif
extern "C" void kernel_launch(void* const* d_in, const int* in_sizes, int n_in, void* d_out, int out_size, void* d_ws, size_t ws_size, hipStream_t stream) {
    static int grid = 0;
    if (grid == 0) {
        if (n_in != 21 || out_size != MT * 1024 || ws_size < WS_END) { fprintf(stderr, "kernel_launch: unexpected shapes (n_in %d, out %d, ws %zu): nothing launched\n", n_in, out_size, ws_size); grid = -1; return; }
        int dev = 0, cus = 0, per_cu = 0;
        if (hipGetDevice(&dev) != hipSuccess || hipDeviceGetAttribute(&cus, hipDeviceAttributeMultiprocessorCount, dev) != hipSuccess) { fprintf(stderr, "kernel_launch: device query failed\n"); grid = -1; return; }
        if (hipFuncSetAttribute((const void*)trunk_fwd, hipFuncAttributeMaxDynamicSharedMemorySize, LDS_BYTES) != hipSuccess) { fprintf(stderr, "kernel_launch: hipFuncSetAttribute failed\n"); grid = -1; return; }
        if (hipOccupancyMaxActiveBlocksPerMultiprocessor(&per_cu, (const void*)trunk_fwd, 512, LDS_BYTES) != hipSuccess || per_cu < 1) { fprintf(stderr, "kernel_launch: occupancy query says %d blocks per CU\n", per_cu); per_cu = 1; }
        (void)hipGetLastError();
        grid = cus * per_cu;
    }
    if (grid < 0) return;
    Args a{};
    for (int i = 0; i < 21; ++i) a.in[i] = d_in[i];
    a.out = (float*)d_out; a.ws = (unsigned char*)d_ws;
    void* args[] = {&a};
    if (hipMemsetAsync((char*)d_ws + WS_CTL, 0, 40960, stream) != hipSuccess) { fprintf(stderr, "kernel_launch: hipMemsetAsync of the barrier words failed\n"); return; }
#if DBG
    dbg_run(a, args, grid, stream);
#elif N_LAUNCH_MODE == 1
    a.ph_lo = 0; a.ph_hi = NPH;
    hipError_t e = hipLaunchCooperativeKernel((const void*)trunk_fwd, dim3(grid), dim3(512), args, LDS_BYTES, stream);
    if (e != hipSuccess) fprintf(stderr, "cooperative launch failed: %s (grid %d)\n", hipGetErrorString(e), grid);
#else
    for (int ph = 0; ph < NPH; ++ph) { a.ph_lo = ph; a.ph_hi = ph + 1;
        hipError_t e = hipLaunchCooperativeKernel((const void*)trunk_fwd, dim3(grid), dim3(512), args, LDS_BYTES, stream);
        if (e != hipSuccess) { fprintf(stderr, "launch of phase %d failed: %s (grid %d)\n", ph, hipGetErrorString(e), grid); break; } }
#endif
}
```
